# Optimizing an MI355X kernel written in HIP

```python
import math
import jax, jax.numpy as jnp
from jax import lax
import numpy as np

D_MODEL = 1024
BATCH = 4
SEQ = 8192
DEPTH = 1

GRID_W = 64
CTX_LEN = 256
MIX_DIM = D_MODEL
ATT_DIM = MIX_DIM // 2
CONV_DIM = MIX_DIM - ATT_DIM
HEAD_DIM = 64
N_HEADS = ATT_DIM // HEAD_DIM
NA_ROWS = 8
NA_COLS = 16
CONV_WIDTH = 31
D_FF = 4 * D_MODEL
IN_PROJ_DIM = 3 * ATT_DIM + 2 * CONV_DIM
N_MOD = 6
ROPE_BASE = 10000.0
EPS = 1e-6

kernel_name = 'hymba_na_conformer_dit_block'


def rms_norm(x, g):
    xf = x.astype(jnp.float32)
    y = xf * lax.rsqrt(jnp.mean(xf * xf, axis=-1, keepdims=True) + EPS)
    return (y * g.astype(jnp.float32)).astype(x.dtype)


def modulate(h, shift, scale):
    return h * (1 + scale) + shift


def split_heads(t):
    b, l, _ = t.shape
    return t.reshape(b, l, N_HEADS, HEAD_DIM)


def split_proj(p):
    q = split_heads(p[..., :ATT_DIM])
    k = split_heads(p[..., ATT_DIM:2 * ATT_DIM])
    v = split_heads(p[..., 2 * ATT_DIM:3 * ATT_DIM])
    u = p[..., 3 * ATT_DIM:]
    return q, k, v, u


def rope_half(xh, pos):
    n_pairs = xh.shape[-1] // 2
    inv_freq = ROPE_BASE ** (-jnp.arange(n_pairs, dtype=jnp.float32) / n_pairs)
    ang = pos.astype(jnp.float32)[:, None] * inv_freq[None, :]
    cos = jnp.cos(ang)[None, :, None, :]
    sin = jnp.sin(ang)[None, :, None, :]
    x1 = xh[..., :n_pairs].astype(jnp.float32)
    x2 = xh[..., n_pairs:].astype(jnp.float32)
    return jnp.concatenate([x1 * cos - x2 * sin, x2 * cos + x1 * sin], axis=-1).astype(xh.dtype)


def axial_rope(x, row_pos, col_pos):
    half = HEAD_DIM // 2
    return jnp.concatenate([rope_half(x[..., :half], row_pos),
                            rope_half(x[..., half:], col_pos)], axis=-1)


def conformer_conv(u, kernel, bias, ln_g, ln_b):
    a, b = jnp.split(u, 2, axis=-1)
    h = a * jax.nn.sigmoid(b)
    pad = CONV_WIDTH // 2
    h = lax.conv_general_dilated(h, kernel[:, None, :].astype(h.dtype), window_strides=(1,),
                                 padding=[(pad, pad)], dimension_numbers=('NWC', 'WIO', 'NWC'),
                                 feature_group_count=CONV_DIM) + bias
    hf = h.astype(jnp.float32)
    mu = jnp.mean(hf, axis=-1, keepdims=True)
    var = jnp.mean(jnp.square(hf - mu), axis=-1, keepdims=True)
    hn = (hf - mu) * lax.rsqrt(var + EPS) * ln_g + ln_b
    return jax.nn.silu(hn).astype(u.dtype)


def sq_relu_mlp(h, w1, w2):
    return jnp.square(jax.nn.relu(h @ w1)) @ w2


def context_attention(q, k, v):
    b, lc = q.shape[0], q.shape[1]
    s = jnp.einsum('bqhd,bkhd->bhqk', q, k).astype(jnp.float32) * HEAD_DIM ** -0.5
    p = jax.nn.softmax(s, axis=-1).astype(v.dtype)
    o = jnp.einsum('bhqk,bkhd->bqhd', p, v)
    return o.reshape(b, lc, ATT_DIM)


def neighbourhood_attention(q_rot, q, k_rot, v, k_ctx, v_ctx, rpb):
    b, l, h, dh = q.shape
    rows = l // GRID_W
    kr = min(NA_ROWS, rows)
    scale = dh ** -0.5
    q_rot_g = q_rot.reshape(b, rows, GRID_W, h, dh).transpose(1, 0, 2, 3, 4)
    q_g = q.reshape(b, rows, GRID_W, h, dh).transpose(1, 0, 2, 3, 4)
    k_g = k_rot.reshape(b, rows, GRID_W, h, dh)
    v_g = v.reshape(b, rows, GRID_W, h, dh)
    row_start = np.clip(np.arange(rows) - kr // 2, 0, rows - kr).astype(np.int32)
    col_start = np.clip(np.arange(GRID_W) - NA_COLS // 2, 0, GRID_W - NA_COLS)
    col_idx = (col_start[:, None] + np.arange(NA_COLS)[None, :]).astype(np.int32)
    col_off = (col_idx - np.arange(GRID_W)[:, None] + (NA_COLS - 1)).astype(np.int32)
    rpb_cols = rpb[:, :, col_off]

    def one_row(args):
        qr_rot, qr, r, rs = args
        k_rows = lax.dynamic_slice_in_dim(k_g, rs, kr, axis=1)
        v_rows = lax.dynamic_slice_in_dim(v_g, rs, kr, axis=1)
        kw = k_rows[:, :, col_idx]
        vw = v_rows[:, :, col_idx]
        row_off = rs + jnp.arange(kr) - r + (NA_ROWS - 1)
        bias = rpb_cols[:, row_off].transpose(0, 2, 1, 3)
        s_win = jnp.einsum('bqhd,biqjhd->bhqij', qr_rot, kw).astype(jnp.float32) * scale
        s_win = (s_win + bias.astype(jnp.float32)[None]).reshape(b, h, GRID_W, kr * NA_COLS)
        s_ctx = jnp.einsum('bqhd,bchd->bhqc', qr, k_ctx).astype(jnp.float32) * scale
        p = jax.nn.softmax(jnp.concatenate([s_win, s_ctx], axis=-1), axis=-1).astype(v.dtype)
        p_win = p[..., :kr * NA_COLS].reshape(b, h, GRID_W, kr, NA_COLS)
        p_ctx = p[..., kr * NA_COLS:]
        return (jnp.einsum('bhqij,biqjhd->bqhd', p_win, vw)
                + jnp.einsum('bhqc,bchd->bqhd', p_ctx, v_ctx))

    out = lax.map(one_row, (q_rot_g, q_g, jnp.arange(rows, dtype=jnp.int32), jnp.asarray(row_start)))
    return out.transpose(1, 0, 2, 3, 4).reshape(b, l, h * dh)


def setup_inputs(seed: int = 0) -> dict:
    key = jax.random.key(seed)
    ks = jax.random.split(key, 18)
    n = jax.random.normal
    return {
        'x': n(ks[0], (BATCH, SEQ, D_MODEL), jnp.float32),
        'c': n(ks[1], (BATCH, D_MODEL), jnp.float32),
        'ctx': n(ks[2], (BATCH, CTX_LEN, D_MODEL), jnp.float32),
        'c_ctx': n(ks[3], (D_MODEL,), jnp.float32),
        'w_ada': n(ks[4], (DEPTH, D_MODEL, N_MOD * D_MODEL), jnp.float32) * (0.5 * D_MODEL ** -0.5),
        'b_ada': 0.02 * n(ks[5], (DEPTH, N_MOD * D_MODEL), jnp.float32),
        'norm1_g': 1.0 + 0.02 * n(ks[6], (DEPTH, D_MODEL), jnp.float32),
        'norm2_g': 1.0 + 0.02 * n(ks[7], (DEPTH, D_MODEL), jnp.float32),
        'w_in': n(ks[8], (DEPTH, D_MODEL, IN_PROJ_DIM), jnp.float32) * D_MODEL ** -0.5,
        'dw_kernel': n(ks[9], (DEPTH, CONV_WIDTH, CONV_DIM), jnp.float32) * CONV_WIDTH ** -0.5,
        'dw_bias': 0.02 * n(ks[10], (DEPTH, CONV_DIM), jnp.float32),
        'conv_ln_g': 1.0 + 0.02 * n(ks[11], (DEPTH, CONV_DIM), jnp.float32),
        'conv_ln_b': 0.02 * n(ks[12], (DEPTH, CONV_DIM), jnp.float32),
        'rpb': 0.5 * n(ks[13], (DEPTH, N_HEADS, 2 * NA_ROWS - 1, 2 * NA_COLS - 1), jnp.float32),
        'w_out': n(ks[14], (DEPTH, MIX_DIM, D_MODEL), jnp.float32) * MIX_DIM ** -0.5,
        'w_mlp1': n(ks[15], (DEPTH, D_MODEL, D_FF), jnp.float32) * D_MODEL ** -0.5,
        'w_mlp2': n(ks[16], (DEPTH, D_FF, D_MODEL), jnp.float32) * D_FF ** -0.5,
        'final_g': 1.0 + 0.02 * n(ks[17], (D_MODEL,), jnp.float32),
    }


def reference(x, c, ctx, c_ctx, w_ada, b_ada, norm1_g, norm2_g, w_in, dw_kernel, dw_bias,
              conv_ln_g, conv_ln_b, rpb, w_out, w_mlp1, w_mlp2, final_g):
    l = x.shape[1]
    t = jnp.arange(l, dtype=jnp.int32)
    row_pos = t // GRID_W
    col_pos = t % GRID_W
    silu_c = jax.nn.silu(c)
    silu_cc = jax.nn.silu(c_ctx)[None]
    for i in range(DEPTH):
        last = i == DEPTH - 1
        mod_x = (silu_c @ w_ada[i] + b_ada[i])[:, None, :]
        mod_c = (silu_cc @ w_ada[i] + b_ada[i])[:, None, :]
        sh1, sc1, g1, sh2, sc2, g2 = jnp.split(mod_x, N_MOD, axis=-1)
        csh1, csc1, cg1, csh2, csc2, cg2 = jnp.split(mod_c, N_MOD, axis=-1)

        hx = modulate(rms_norm(x, norm1_g[i]), sh1, sc1)
        hc = modulate(rms_norm(ctx, norm1_g[i]), csh1, csc1)
        qx, kx, vx, ux = split_proj(hx @ w_in[i])
        if last:
            kvc = hc @ w_in[i][:, ATT_DIM:3 * ATT_DIM]
            kc, vc = split_heads(kvc[..., :ATT_DIM]), split_heads(kvc[..., ATT_DIM:])
        else:
            qc, kc, vc, uc = split_proj(hc @ w_in[i])

        qx_rot = axial_rope(qx, row_pos, col_pos)
        kx_rot = axial_rope(kx, row_pos, col_pos)
        attn_x = neighbourhood_attention(qx_rot, qx, kx_rot, vx, kc, vc, rpb[i])
        conv_x = conformer_conv(ux, dw_kernel[i], dw_bias[i], conv_ln_g[i], conv_ln_b[i])
        x_new = x + g1 * (jnp.concatenate([attn_x, conv_x], axis=-1) @ w_out[i])

        hx2 = modulate(rms_norm(x_new, norm2_g[i]), sh2, sc2)
        x_new = x_new + g2 * sq_relu_mlp(hx2, w_mlp1[i], w_mlp2[i])

        if not last:
            attn_c = context_attention(qc, kc, vc)
            conv_c = conformer_conv(uc, dw_kernel[i], dw_bias[i], conv_ln_g[i], conv_ln_b[i])
            ctx = ctx + cg1 * (jnp.concatenate([attn_c, conv_c], axis=-1) @ w_out[i])
            hc2 = modulate(rms_norm(ctx, norm2_g[i]), csh2, csc2)
            ctx = ctx + cg2 * sq_relu_mlp(hc2, w_mlp1[i], w_mlp2[i])
        x = x_new
    return rms_norm(x, final_g)
```

```cpp
#include <hip/hip_runtime.h>
#include <cstdio>
#include <cstdint>
namespace pg8 {
#define PG8_LAS __attribute__((address_space(3)))
typedef unsigned short bf16_t;
typedef short bf16x8 __attribute__((ext_vector_type(8)));
typedef float f32x4 __attribute__((ext_vector_type(4)));
typedef unsigned u32x4 __attribute__((ext_vector_type(4)));
constexpr int BM = 256, BK = 64, HALF = 128, HTB = HALF * BK * 2  , STAGE_BYTES = 8 * HTB, NXCD = 8, WGM = 8;

__host__ __device__ __forceinline__ int lds_byte(int r, int c) { const int st = (r >> 4) * 2 + (c >> 5), rr = r & 15, cc = c & 31, ob = rr * 64 + cc * 2; return st * 1024 + (ob ^ (((ob >> 9) & 1) << 5)); }
__host__ __device__ __forceinline__ void stage_rc(int b, int& R, int& C) { const int st = b / 1024, sb = b % 1024, swz = sb ^ (((sb >> 9) & 1) << 5); R = (st >> 1) * 16 + swz / 64; C = (st & 1) * 32 + (swz % 64) / 2; }
__host__ __device__ __forceinline__ int perm32(int rho) { const int n = rho >> 4, i = rho & 15; return 8 * (i >> 2) + 4 * n + (i & 3); }

struct Unit { int pm, pn; };
struct Gemm { const bf16_t* A; const bf16_t* Bt; int M, N, K; };

struct StaticOrder {
    int nM, nN, nwg, G, c;
    __host__ __device__ void init(int M, int N, int G_, int c_) { nM = M / BM; nN = N / BM; nwg = nM * nN; G = G_; c = c_; }
    __host__ __device__ bool next(int i, Unit& u) const {
        const long L = (long)i * G + c; if (L >= nwg) return false;
        int wgid = (int)L; { const int q = nwg / NXCD, r = nwg % NXCD, xcd = wgid % NXCD, off = wgid / NXCD; wgid = (xcd < r ? xcd * (q + 1) : r * (q + 1) + (xcd - r) * q) + off; }
        const int nig = WGM * nN, gid = wgid / nig, fm = gid * WGM, gsz = (nM - fm) < WGM ? (nM - fm) : WGM;
        u.pm = fm + ((wgid % nig) % gsz); u.pn = (wgid % nig) / gsz; return true;
    }
    __device__ __forceinline__ void a_ready(const Unit&) const {}
    __device__ __forceinline__ void done(const Unit&) const {}
};


typedef float f32x2 __attribute__((ext_vector_type(2)));
typedef __bf16 bf16x2_t __attribute__((ext_vector_type(2)));
typedef unsigned u32x2 __attribute__((ext_vector_type(2)));
__device__ __forceinline__ unsigned cvt_pk_bf16(float lo, float hi) { f32x2 v = {lo, hi}; bf16x2_t b = __builtin_convertvector(v, bf16x2_t); return __builtin_bit_cast(unsigned, b); }
__device__ __forceinline__ u32x4 pack8(f32x4 a, f32x4 b) { u32x4 w; w.x = cvt_pk_bf16(a[0], a[1]); w.y = cvt_pk_bf16(a[2], a[3]); w.z = cvt_pk_bf16(b[0], b[1]); w.w = cvt_pk_bf16(b[2], b[3]); return w; }
constexpr float QSCALE = 0.125f * 1.4426950408889634f;
constexpr int SEQ_L = 8192, GRID_WL = 64;

struct EpiInProj {
    static constexpr bool PERM = true, AFTER_DRAIN = false;
    bf16_t *Q, *QROT, *KROT, *V, *HG; const float* rope;
    __device__ __forceinline__ void operator()(const f32x4 (&acc)[2][2][4][2], const Unit& u, int wr, int wc, int fr, int fq) const {
        const int row0 = u.pm * BM + wr * 64 + fr; const int pn = u.pn;
        if (pn < 4) {
            const int cb = (pn & 1) * 256 + wc * 32 + 8 * fq; const int axis = wc & 1;
#pragma unroll
            for (int ai = 0; ai < 2; ++ai)
#pragma unroll
                for (int m = 0; m < 4; ++m) {
                    const int row = row0 + ai * HALF + m * 16, tok = row & (SEQ_L - 1), pos = axis ? (tok & (GRID_WL - 1)) : (tok >> 6);
                    const f32x4* rp = (const f32x4*)(rope + (pos * 16 + 4 * fq) * 2); const f32x4 cs0 = rp[0], cs1 = rp[1];
                    const f32x4 c = {cs0[0], cs0[2], cs1[0], cs1[2]}, s = {cs0[1], cs0[3], cs1[1], cs1[3]};
#pragma unroll
                    for (int bj = 0; bj < 2; ++bj) {
                        const f32x4 x1 = acc[ai][bj][m][0], x2 = acc[ai][bj][m][1];
                        const f32x4 r1 = x1 * c - x2 * s, r2 = x2 * c + x1 * s;
                        const size_t off = (size_t)row * 512 + cb + bj * HALF;
                        if (pn < 2) { *(u32x4*)(Q + off) = pack8(x1 * QSCALE, x2 * QSCALE); *(u32x4*)(QROT + off) = pack8(r1 * QSCALE, r2 * QSCALE); }
                        else *(u32x4*)(KROT + off) = pack8(r1, r2);
                    }
                }
        } else if (pn < 6) {
            const int cb = (pn & 1) * 256 + wc * 32 + 8 * fq;
#pragma unroll
            for (int ai = 0; ai < 2; ++ai)
#pragma unroll
                for (int m = 0; m < 4; ++m) { const int row = row0 + ai * HALF + m * 16;
#pragma unroll
                    for (int bj = 0; bj < 2; ++bj) *(u32x4*)(V + (size_t)row * 512 + cb + bj * HALF) = pack8(acc[ai][bj][m][0], acc[ai][bj][m][1]); }
        } else {
            const int cb = (pn - 6) * 128 + wc * 32 + 8 * fq;
#pragma unroll
            for (int ai = 0; ai < 2; ++ai)
#pragma unroll
                for (int m = 0; m < 4; ++m) { const int row = row0 + ai * HALF + m * 16; f32x4 h[2];
#pragma unroll
                    for (int n = 0; n < 2; ++n) { const f32x4 a = acc[ai][0][m][n], b = acc[ai][1][m][n];
#pragma unroll
                        for (int e = 0; e < 4; ++e) h[n][e] = a[e] * __builtin_amdgcn_rcpf(1.0f + __builtin_amdgcn_exp2f(-1.4426950408889634f * b[e])); }
                    *(u32x4*)(HG + (size_t)row * 512 + cb) = pack8(h[0], h[1]); }
        }
    }
};
struct EpiCtx {
    static constexpr bool PERM = true, AFTER_DRAIN = false;
    bf16_t *KC, *VC;
    __device__ __forceinline__ void operator()(const f32x4 (&acc)[2][2][4][2], const Unit& u, int wr, int wc, int fr, int fq) const {
        const int row0 = u.pm * BM + wr * 64 + fr; bf16_t* O = u.pn < 2 ? KC : VC; const int cb = (u.pn & 1) * 256 + wc * 32 + 8 * fq;
#pragma unroll
        for (int ai = 0; ai < 2; ++ai)
#pragma unroll
            for (int m = 0; m < 4; ++m) { const int row = row0 + ai * HALF + m * 16;
#pragma unroll
                for (int bj = 0; bj < 2; ++bj) *(u32x4*)(O + (size_t)row * 512 + cb + bj * HALF) = pack8(acc[ai][bj][m][0], acc[ai][bj][m][1]); }
    }
};
struct EpiOutProj {
    static constexpr bool PERM = false, AFTER_DRAIN = false;
    const float* X; float* XN; bf16_t* XS; float* SSQ; const float* mod; const float* S2;
    __device__ __forceinline__ void operator()(const f32x4 (&acc)[2][2][4][2], const Unit& u, int wr, int wc, int fr, int fq) const {
        const int row0 = u.pm * BM + wr * 64 + fr, col0 = u.pn * BM + wc * 32 + 4 * fq; const int b = (u.pm * BM) >> 13;
        f32x4 g1[2][2], s2[2][2];
#pragma unroll
        for (int bj = 0; bj < 2; ++bj)
#pragma unroll
            for (int n = 0; n < 2; ++n) { g1[bj][n] = *(const f32x4*)(mod + b * 6144 + 2048 + col0 + bj * HALF + n * 16); s2[bj][n] = *(const f32x4*)(S2 + b * 1024 + col0 + bj * HALF + n * 16); }
#pragma unroll
        for (int ai = 0; ai < 2; ++ai)
#pragma unroll
            for (int m = 0; m < 4; ++m) { const int row = row0 + ai * HALF + m * 16; const size_t off = (size_t)row * 1024 + col0; float q = 0.f;
#pragma unroll
                for (int bj = 0; bj < 2; ++bj)
#pragma unroll
                    for (int n = 0; n < 2; ++n) { const f32x4 xv = *(const f32x4*)(X + off + bj * HALF + n * 16); const f32x4 xn = xv + g1[bj][n] * acc[ai][bj][m][n];
                        *(f32x4*)(XN + off + bj * HALF + n * 16) = xn; q += (xn[0] * xn[0] + xn[1] * xn[1]) + (xn[2] * xn[2] + xn[3] * xn[3]);
                        const f32x4 xs = xn * s2[bj][n]; u32x2 w; w.x = cvt_pk_bf16(xs[0], xs[1]); w.y = cvt_pk_bf16(xs[2], xs[3]); *(u32x2*)(XS + off + bj * HALF + n * 16) = w; }
                q += __shfl_xor(q, 16); q += __shfl_xor(q, 32);
                if (fq == 0) SSQ[(size_t)row * 16 + u.pn * 4 + wc] = q; }
    }
};
struct EpiMlp1 {
    static constexpr bool PERM = true, AFTER_DRAIN = false;
    bf16_t* HID; const float* SSQ; const float* BIAS2; float eps;
    __device__ __forceinline__ void operator()(const f32x4 (&acc)[2][2][4][2], const Unit& u, int wr, int wc, int fr, int fq) const {
        const int row0 = u.pm * BM + wr * 64 + fr, col0 = u.pn * BM + wc * 32 + 8 * fq; const int b = (u.pm * BM) >> 13;
        f32x4 bv[2][2];
#pragma unroll
        for (int bj = 0; bj < 2; ++bj)
#pragma unroll
            for (int n = 0; n < 2; ++n) bv[bj][n] = *(const f32x4*)(BIAS2 + b * 4096 + col0 + bj * HALF + 4 * n);
#pragma unroll
        for (int ai = 0; ai < 2; ++ai)
#pragma unroll
            for (int m = 0; m < 4; ++m) { const int row = row0 + ai * HALF + m * 16; const f32x4* sp = (const f32x4*)(SSQ + (size_t)row * 16);
                const f32x4 s0 = sp[0], s1 = sp[1], s2 = sp[2], s3 = sp[3];
                const float ss = ((s0[0] + s0[1]) + (s0[2] + s0[3])) + ((s1[0] + s1[1]) + (s1[2] + s1[3])) + ((s2[0] + s2[1]) + (s2[2] + s2[3])) + ((s3[0] + s3[1]) + (s3[2] + s3[3]));
                const float rstd = 1.0f / sqrtf(ss * (1.0f / 1024.0f) + eps);
#pragma unroll
                for (int bj = 0; bj < 2; ++bj) { f32x4 v0 = acc[ai][bj][m][0] * rstd + bv[bj][0], v1 = acc[ai][bj][m][1] * rstd + bv[bj][1];
#pragma unroll
                    for (int e = 0; e < 4; ++e) { const float a0 = fmaxf(v0[e], 0.f), a1 = fmaxf(v1[e], 0.f); v0[e] = a0 * a0; v1[e] = a1 * a1; }
                    *(u32x4*)(HID + (size_t)row * 4096 + col0 + bj * HALF) = pack8(v0, v1); } }
    }
};
struct EpiMlp2 {
    static constexpr bool PERM = false, AFTER_DRAIN = false;
    float* Y; float* SSQ; const float* mod;
    __device__ __forceinline__ void operator()(const f32x4 (&acc)[2][2][4][2], const Unit& u, int wr, int wc, int fr, int fq) const {
        const int row0 = u.pm * BM + wr * 64 + fr, col0 = u.pn * BM + wc * 32 + 4 * fq; const int b = (u.pm * BM) >> 13;
        f32x4 g2[2][2];
#pragma unroll
        for (int bj = 0; bj < 2; ++bj)
#pragma unroll
            for (int n = 0; n < 2; ++n) g2[bj][n] = *(const f32x4*)(mod + b * 6144 + 5120 + col0 + bj * HALF + n * 16);
#pragma unroll
        for (int ai = 0; ai < 2; ++ai)
#pragma unroll
            for (int m = 0; m < 4; ++m) { const int row = row0 + ai * HALF + m * 16; const size_t off = (size_t)row * 1024 + col0; float q = 0.f;
#pragma unroll
                for (int bj = 0; bj < 2; ++bj)
#pragma unroll
                    for (int n = 0; n < 2; ++n) { const f32x4 xv = *(const f32x4*)(Y + off + bj * HALF + n * 16); const f32x4 y = xv + g2[bj][n] * acc[ai][bj][m][n];
                        *(f32x4*)(Y + off + bj * HALF + n * 16) = y; q += (y[0] * y[0] + y[1] * y[1]) + (y[2] * y[2] + y[3] * y[3]); }
                q += __shfl_xor(q, 16); q += __shfl_xor(q, 32);
                if (fq == 0) SSQ[(size_t)row * 16 + u.pn * 4 + wc] = q; }
    }
};

template <class Epi, class Sched, bool ALIGN_EPI = false, bool SP2 = false>
__device__ __forceinline__ void gemm_phase(PG8_LAS unsigned char* lds, const Gemm g, const Sched& S, const Epi& E) {
    const int tid = threadIdx.x, wid = __builtin_amdgcn_readfirstlane(tid >> 6), lane = tid & 63, wr = wid >> 2, wc = wid & 3, fr = lane & 15, fq = lane >> 4;
    const int K = g.K, nt = K / BK;
    unsigned voffA[2], voffB[2];
#pragma unroll
    for (int i = 0; i < 2; ++i) { int R, C; stage_rc(tid * 16 + i * 8192, R, C); const int Rb = Epi::PERM ? ((R & ~31) + perm32(R & 31)) : R;
        voffA[i] = (unsigned)(R * K + C) * 2u; voffB[i] = (unsigned)(Rb * K + C) * 2u; }
    const size_t kstep = (size_t)(BK * 2);
    const size_t hstep = (size_t)HALF * K * 2;
    const size_t tstep = 2 * hstep;
    const unsigned ldsw = (unsigned)wid * 1024u;
    const int aoff = lds_byte(wr * 64 + fr, fq * 8), boff = lds_byte(wc * 32 + fr, fq * 8);
#define PG8_SA(b, h) (((b) * 2 + (h)) * HTB)
#define PG8_SB(b, h) ((4 + (b) * 2 + (h)) * HTB)
#define PG8_STAGE(bufoff, gbase, voff) do { _Pragma("unroll") for (int _i = 0; _i < 2; ++_i) \
        __builtin_amdgcn_global_load_lds((const unsigned*)((const char*)(gbase) + (voff)[_i]), (PG8_LAS unsigned*)(lds + (bufoff) + ldsw + _i * 8192), 16, 0, 0); } while (0)
#define PG8_LDA(dst, b, h) do { _Pragma("unroll") for (int m = 0; m < 4; ++m) _Pragma("unroll") for (int k = 0; k < 2; ++k) dst[m][k] = *(const PG8_LAS bf16x8*)(lds + PG8_SA(b, h) + aoff + m * 2048 + k * 1024); } while (0)
#define PG8_LDB(dst, b, h) do { _Pragma("unroll") for (int n = 0; n < 2; ++n) _Pragma("unroll") for (int k = 0; k < 2; ++k) dst[n][k] = *(const PG8_LAS bf16x8*)(lds + PG8_SB(b, h) + boff + n * 2048 + k * 1024); } while (0)
#define PG8_MMA(ai, bj, At, Bt) do { __builtin_amdgcn_s_setprio(1); _Pragma("unroll") for (int m = 0; m < 4; ++m) _Pragma("unroll") for (int n = 0; n < 2; ++n) _Pragma("unroll") for (int k = 0; k < 2; ++k) \
        acc[ai][bj][m][n] = __builtin_amdgcn_mfma_f32_16x16x32_bf16(Bt[n][k], At[m][k], acc[ai][bj][m][n], 0, 0, 0); __builtin_amdgcn_s_setprio(0); } while (0)
#define PG8_WAIT_V(n) asm volatile("s_waitcnt vmcnt(" #n ")" ::: "memory")
#define PG8_WAIT_L(n) asm volatile("s_waitcnt lgkmcnt(" #n ")" ::: "memory")
#define PG8_BAR __builtin_amdgcn_s_barrier()
#define PG8_SCHED __builtin_amdgcn_sched_barrier(0)
    Unit cur, nxt; int ui = 0;
    if (!S.next(0, cur)) return;
    f32x4 acc[2][2][4][2];
#pragma unroll
    for (int a = 0; a < 2; ++a)
#pragma unroll
        for (int b = 0; b < 2; ++b)
#pragma unroll
            for (int m = 0; m < 4; ++m)
#pragma unroll
                for (int n = 0; n < 2; ++n) acc[a][b][m][n] = (f32x4){0.f, 0.f, 0.f, 0.f};
    bf16x8 At[4][2], B0[2][2], B1[2][2];
    const char* cA = (const char*)g.A + (size_t)cur.pm * tstep; const char* cB = (const char*)g.Bt + (size_t)cur.pn * tstep;
    S.a_ready(cur);
    if constexpr (SP2) {
        PG8_STAGE(PG8_SB(0, 0), cB, voffB); PG8_STAGE(PG8_SB(0, 1), cB + hstep, voffB); PG8_STAGE(PG8_SA(0, 0), cA, voffA); PG8_STAGE(PG8_SA(0, 1), cA + hstep, voffA);
        if (wr == 1) PG8_BAR;
        PG8_WAIT_V(2); PG8_BAR;
        PG8_STAGE(PG8_SB(1, 0), cB + kstep, voffB); PG8_STAGE(PG8_SA(1, 0), cA + kstep, voffA); PG8_STAGE(PG8_SB(1, 1), cB + hstep + kstep, voffB);
        PG8_WAIT_V(6); PG8_BAR;
    } else {
        PG8_STAGE(PG8_SB(0, 0), cB, voffB); PG8_STAGE(PG8_SA(0, 0), cA, voffA); PG8_STAGE(PG8_SB(0, 1), cB + hstep, voffB); PG8_STAGE(PG8_SA(0, 1), cA + hstep, voffA);
        if (wr == 1) PG8_BAR;
        PG8_WAIT_V(4); PG8_BAR;
        PG8_STAGE(PG8_SB(1, 0), cB + kstep, voffB); PG8_STAGE(PG8_SA(1, 0), cA + kstep, voffA); PG8_STAGE(PG8_SB(1, 1), cB + hstep + kstep, voffB);
        PG8_WAIT_V(6); PG8_BAR;
    }
    for (;;) {
        const bool has_next = S.next(ui + 1, nxt);
        const char* nA = has_next ? (const char*)g.A + (size_t)nxt.pm * tstep : cA; const char* nB = has_next ? (const char*)g.Bt + (size_t)nxt.pn * tstep : cB;
        for (int t = 0; t < nt; t += 2) {
            const bool last = (t == nt - 2);
            const char* a1 = cA + (size_t)(t + 1) * kstep;
            const char* a2 = last ? nA : cA + (size_t)(t + 2) * kstep; const char* b2 = last ? nB : cB + (size_t)(t + 2) * kstep;
            const char* a3 = a2 + kstep; const char* b3 = b2 + kstep;
            if (last && has_next) S.a_ready(nxt);
            if constexpr (SP2) {
            PG8_LDB(B0, 0, 0); PG8_LDB(B1, 0, 1); PG8_SCHED; PG8_LDA(At, 0, 0); PG8_STAGE(PG8_SA(1, 1), a1 + hstep, voffA);
            PG8_WAIT_V(8); PG8_WAIT_L(0); PG8_BAR; PG8_MMA(0, 0, At, B0); PG8_MMA(0, 1, At, B1); PG8_BAR; PG8_SCHED;
            PG8_LDA(At, 0, 1); PG8_STAGE(PG8_SB(0, 0), b2, voffB); PG8_STAGE(PG8_SB(0, 1), b2 + hstep, voffB); PG8_STAGE(PG8_SA(0, 0), a2, voffA);
            PG8_WAIT_V(8); PG8_WAIT_L(0); PG8_BAR; PG8_MMA(1, 0, At, B0); PG8_MMA(1, 1, At, B1); PG8_BAR; PG8_SCHED;
            PG8_LDB(B0, 1, 0); PG8_LDB(B1, 1, 1); PG8_SCHED; PG8_LDA(At, 1, 0); PG8_STAGE(PG8_SA(0, 1), a2 + hstep, voffA);
            PG8_WAIT_V(8); PG8_WAIT_L(0); PG8_BAR; PG8_MMA(0, 0, At, B0); PG8_MMA(0, 1, At, B1); PG8_BAR; PG8_SCHED;
            PG8_LDA(At, 1, 1); PG8_STAGE(PG8_SB(1, 0), b3, voffB); PG8_STAGE(PG8_SB(1, 1), b3 + hstep, voffB); PG8_STAGE(PG8_SA(1, 0), a3, voffA);
            PG8_WAIT_V(8); PG8_WAIT_L(0); PG8_BAR; PG8_MMA(1, 0, At, B0); PG8_MMA(1, 1, At, B1); PG8_BAR; PG8_SCHED;
            } else {
            PG8_LDB(B0, 0, 0); PG8_SCHED; PG8_LDA(At, 0, 0); PG8_STAGE(PG8_SA(1, 1), a1 + hstep, voffA);
            PG8_WAIT_L(8); PG8_BAR; PG8_WAIT_L(0); PG8_MMA(0, 0, At, B0); PG8_BAR; PG8_SCHED;
            PG8_LDB(B1, 0, 1); PG8_STAGE(PG8_SB(0, 0), b2, voffB);
            PG8_BAR; PG8_WAIT_L(0); PG8_MMA(0, 1, At, B1); PG8_BAR;
            PG8_LDA(At, 0, 1); PG8_STAGE(PG8_SA(0, 0), a2, voffA);
            PG8_BAR; PG8_WAIT_L(0); PG8_MMA(1, 0, At, B0); PG8_BAR; PG8_SCHED;
            PG8_STAGE(PG8_SB(0, 1), b2 + hstep, voffB);
            PG8_WAIT_V(6); PG8_BAR; PG8_MMA(1, 1, At, B1); PG8_BAR;
            PG8_LDB(B0, 1, 0); PG8_SCHED; PG8_LDA(At, 1, 0); PG8_STAGE(PG8_SA(0, 1), a2 + hstep, voffA);
            PG8_WAIT_L(8); PG8_BAR; PG8_WAIT_L(0); PG8_MMA(0, 0, At, B0); PG8_BAR; PG8_SCHED;
            PG8_LDB(B1, 1, 1); PG8_STAGE(PG8_SB(1, 0), b3, voffB);
            PG8_BAR; PG8_WAIT_L(0); PG8_MMA(0, 1, At, B1); PG8_BAR;
            PG8_LDA(At, 1, 1); PG8_STAGE(PG8_SA(1, 0), a3, voffA);
            PG8_BAR; PG8_WAIT_L(0); PG8_MMA(1, 0, At, B0); PG8_BAR; PG8_SCHED;
            PG8_STAGE(PG8_SB(1, 1), b3 + hstep, voffB);
            PG8_WAIT_V(6); PG8_BAR; PG8_MMA(1, 1, At, B1); PG8_BAR;
            }
        }
        if constexpr (ALIGN_EPI) { if (wr == 0) PG8_BAR; }
        if constexpr (!Epi::AFTER_DRAIN) { E(acc, cur, wr, wc, fr, fq); S.done(cur); }
        if (!has_next) break;
#pragma unroll
        for (int a = 0; a < 2; ++a)
#pragma unroll
            for (int b = 0; b < 2; ++b)
#pragma unroll
                for (int m = 0; m < 4; ++m)
#pragma unroll
                    for (int n = 0; n < 2; ++n) acc[a][b][m][n] = (f32x4){0.f, 0.f, 0.f, 0.f};
        cur = nxt; cA = nA; cB = nB; ++ui;
        if constexpr (ALIGN_EPI) { if (wr == 1) PG8_BAR; }
    }
    PG8_WAIT_V(0);
    if constexpr (!ALIGN_EPI) { if (wr == 0) PG8_BAR; }
    PG8_BAR;
    if constexpr (Epi::AFTER_DRAIN) { E.fused(acc, cur, wr, wc, fr, fq, lds, wid, lane); S.done(cur); }
#undef PG8_SA
#undef PG8_SB
#undef PG8_STAGE
#undef PG8_LDA
#undef PG8_LDB
#undef PG8_MMA
#undef PG8_WAIT_V
#undef PG8_WAIT_L
#undef PG8_BAR
#undef PG8_SCHED
}
}
#define GAS __attribute__((address_space(1)))
#define LAS __attribute__((address_space(3)))
typedef unsigned short bf16;
typedef unsigned v4u __attribute__((ext_vector_type(4)));
typedef float f32x4 __attribute__((ext_vector_type(4)));
typedef short bf16x8 __attribute__((ext_vector_type(8)));
typedef GAS unsigned gu32;
typedef GAS unsigned long long gu64;
#define RLX_AGENT __ATOMIC_RELAXED, __HIP_MEMORY_SCOPE_AGENT
#define LDS_WAIT() asm volatile("s_waitcnt lgkmcnt(0)" ::: "memory")
#define VM_WAIT() asm volatile("s_waitcnt vmcnt(0)" ::: "memory")
__device__ __forceinline__ unsigned long long rt() { return __builtin_amdgcn_s_memrealtime(); }
__device__ __forceinline__ unsigned f2bf(float f) { unsigned u = __builtin_bit_cast(unsigned, f); return (u + 0x7fffu + ((u >> 16) & 1u)) >> 16; }
__device__ __forceinline__ unsigned pk2(float lo, float hi) { return f2bf(lo) | (f2bf(hi) << 16); }

#define XB_TMO      128
#define XB_XCNT(j)  (256  + 64 * (j))
#define XB_XSUB(j)  (1280 + 64 * (j))
#define XB_XGEN(j)  (2304 + 64 * (j))
#define XB_TOP      3328
#define XB_TOPGEN   3392
#define XCD_BAR_WORDS 3456
#define XB_SPIN_CAP (1u << 18)

__device__ __forceinline__ unsigned xb_ld(unsigned* p)              { return __hip_atomic_load(p, __ATOMIC_RELAXED, __HIP_MEMORY_SCOPE_AGENT); }
__device__ __forceinline__ unsigned xb_add(unsigned* p, unsigned v) { return __hip_atomic_fetch_add(p, v, __ATOMIC_RELAXED, __HIP_MEMORY_SCOPE_AGENT); }
__device__ __forceinline__ unsigned xb_xcc_id() { return (unsigned)__builtin_amdgcn_s_getreg((3 << 11) | 20) & 0xFu; }
#define XB_SPIN(cond, bar) do { unsigned _sp = 0; while (cond) { __builtin_amdgcn_s_sleep(1); \
    if ((++_sp & 255u) == 0u) { if (xb_ld(&(bar)[XB_TMO])) break; if (_sp > XB_SPIN_CAP) { atomicAdd(&(bar)[XB_TMO], 1u); break; } } } } while (0)

struct XcdBarrier {
    unsigned* bar; unsigned x;
    volatile LAS unsigned* st;
};

__device__ __forceinline__ XcdBarrier xcd_barrier_post(unsigned* bar, volatile LAS unsigned* st) {
    XcdBarrier b; b.bar = bar; b.x = xb_xcc_id(); b.st = st;
    if (threadIdx.x == 0) (void)xb_add(&bar[XB_XCNT(b.x)], 1u);
    return b;
}
__device__ __forceinline__ void xcd_barrier_complete(unsigned* bar, unsigned x, unsigned& nloc, unsigned& nx) {
    const unsigned G = gridDim.x * gridDim.y * gridDim.z;
    unsigned sum, cnt, mine, sp = 0u;
    for (;;) {
        sum = 0u; cnt = 0u; mine = 0u;
#pragma unroll
        for (unsigned j = 0; j < 16; ++j) { const unsigned c = xb_ld(&bar[XB_XCNT(j)]); sum += c; cnt += (c > 0u) ? 1u : 0u; mine = (j == x) ? c : mine; }
        if (sum == G) break;
        __builtin_amdgcn_s_sleep(1);
        if ((++sp & 255u) == 0u) { if (xb_ld(&bar[XB_TMO])) break; if (sp > XB_SPIN_CAP) { atomicAdd(&bar[XB_TMO], 1u); break; } }
    }
    nloc = mine > 0u ? mine : 1u; nx = cnt > 0u ? cnt : 1u;
}

__device__ __forceinline__ void xcd_barrier(const XcdBarrier& b) {
    asm volatile("s_waitcnt vmcnt(0)" ::: "memory");
    __syncthreads();
    if (threadIdx.x == 0) {
        unsigned* bar = b.bar;
        __builtin_amdgcn_s_waitcnt(0);
        unsigned nloc = b.st[0], nx = b.st[1];
        if (nloc == 0u) { xcd_barrier_complete(bar, b.x, nloc, nx); b.st[0] = nloc; b.st[1] = nx; }
        const unsigned old = xb_add(&bar[XB_XSUB(b.x)], 1u);
        const unsigned gen = old / nloc;
        if (old + 1u == (gen + 1u) * nloc) {
            __builtin_amdgcn_fence(__ATOMIC_RELEASE, "agent");
            asm volatile("s_waitcnt vmcnt(0)" ::: "memory");
            const unsigned og = xb_add(&bar[XB_TOP], 1u);
            const unsigned tg = og / nx;
            if (og + 1u == (tg + 1u) * nx) xb_add(&bar[XB_TOPGEN], 1u);
            else XB_SPIN(xb_ld(&bar[XB_TOPGEN]) == tg, bar);
            __builtin_amdgcn_fence(__ATOMIC_ACQUIRE, "agent");
            xb_add(&bar[XB_XGEN(b.x)], 1u);
            asm volatile("s_waitcnt vmcnt(0)" ::: "memory");
        } else {
            XB_SPIN(xb_ld(&bar[XB_XGEN(b.x)]) == gen, bar);
            __builtin_amdgcn_fence(__ATOMIC_ACQUIRE, "agent");
            asm volatile("s_waitcnt vmcnt(0)" ::: "memory");
        }
    }
    __syncthreads();
}

constexpr int NWAVES = 8;
constexpr int BATCH = 4, SEQ = 8192, D = 1024, FF = 4096, CTXL = 256, NH = 8, HD = 64, ATT = 512, CONVD = 512, NIN = 2560, NMOD = 6 * D, CW = 31;
constexpr int M = BATCH * SEQ;
constexpr int MC = BATCH * CTXL;
constexpr float EPS = 1e-6f, LOG2E = 1.4426950408889634f;
#ifndef MK_N_LAUNCHES
#define MK_N_LAUNCHES 8
#endif
constexpr int N_PHASES = 8;

constexpr size_t MiB = 1u << 20;
constexpr size_t WS_CTL = 0, CTL_ZERO_BYTES = 64 * 1024;
constexpr size_t WS_MOD = 1 * MiB;
constexpr size_t WS_ROPE = WS_MOD + 128 * 1024;
constexpr size_t WS_S2 = WS_ROPE + 16 * 1024;
constexpr size_t WS_BIAS2 = WS_S2 + 16 * 1024;
constexpr size_t WS_WIN = 2 * MiB, WS_WOUT = 7 * MiB, WS_W1 = 9 * MiB, WS_W2 = 17 * MiB;
constexpr size_t WS_HC = 25 * MiB, WS_KC = 27 * MiB, WS_VC = 28 * MiB, WS_SSQ = 29 * MiB, WS_SSQ2 = 31 * MiB;
constexpr size_t WS_XS = 40 * MiB;
constexpr size_t WS_R = 104 * MiB;
constexpr size_t WS_HX = WS_R, WS_MIX = WS_R, WS_QROT = WS_R + 64 * MiB, WS_Q = WS_R + 96 * MiB, WS_KROT = WS_R + 128 * MiB, WS_V = WS_R + 160 * MiB, WS_HG = WS_R + 192 * MiB;
constexpr size_t WS_HID = WS_R, WS_END = WS_R + 256 * MiB;
constexpr int CW_BAR = 1024;

constexpr int RING_OFF = 0, RING_BYTES = 131072;
constexpr int LDSCTL_OFF = RING_BYTES, MISC_OFF = LDSCTL_OFF + 320;
constexpr int LDS_BYTES = 147456;

struct Args { const float* in[18]; float* out; unsigned char* ws; int ph_lo, ph_hi; };

struct Frame {
    LAS unsigned char* lds; volatile LAS unsigned* MISC; gu32* ctl;
    int tid, lane, wave, vcu, G;
};
__device__ __forceinline__ float wave_sum(float v) {
#pragma unroll
    for (int o = 1; o < 64; o <<= 1) v += __shfl_xor(v, o);
    return v;
}
__device__ __forceinline__ float wave_max(float v) {
#pragma unroll
    for (int o = 1; o < 64; o <<= 1) v = fmaxf(v, __shfl_xor(v, o));
    return v;
}
__device__ __forceinline__ float bf_lo(unsigned u) { return __builtin_bit_cast(float, u << 16); }
__device__ __forceinline__ float bf_hi(unsigned u) { return __builtin_bit_cast(float, u & 0xffff0000u); }
__device__ __forceinline__ float bf1(bf16 u) { return __builtin_bit_cast(float, (unsigned)u << 16); }

__host__ __device__ __forceinline__ int win_src(int p) {
    if (p < 1024) { const int g = p & ~31, i = p & 31; return g + 16 * ((i >> 2) & 1) + 4 * (i >> 3) + (i & 3); }
    if (p < 1536) return p;
    const int u = p - 1536, t = u >> 8, w = u & 255;
    return w < 128 ? 1536 + 128 * t + w : 2048 + 128 * t + (w - 128);
}
template <bool PERMW>
__device__ __forceinline__ void p0_transpose_item(const float* W, int K, int N, bf16* WT, LAS float* scr, int item, int lane) {
    const int nblk = N / 32, kb = item / nblk, nb = item % nblk, k0 = 64 * kb, n0 = 32 * nb;
    const int sc = PERMW ? win_src(n0 + (lane & 31)) : n0 + (lane & 31);
#pragma unroll 8
    for (int i = 0; i < 32; ++i) { const int kk = 2 * i + (lane >> 5); scr[kk * 33 + (lane & 31)] = W[(size_t)(k0 + kk) * N + sc]; }
    LDS_WAIT(); asm volatile("" ::: "memory");
    const int c = lane & 7;
#pragma unroll
    for (int j = 0; j < 4; ++j) { const int n = (lane >> 3) + 8 * j; const LAS float* s = scr + (8 * c) * 33 + n;
        v4u o; o.x = pk2(s[0 * 33], s[1 * 33]); o.y = pk2(s[2 * 33], s[3 * 33]); o.z = pk2(s[4 * 33], s[5 * 33]); o.w = pk2(s[6 * 33], s[7 * 33]);
        *(GAS v4u*)(WT + (size_t)(n0 + n) * K + k0 + 8 * c) = o; }
    LDS_WAIT(); asm volatile("" ::: "memory");
}
__device__ __forceinline__ float silu_f(float v) { return v / (1.0f + __expf(-v)); }

__device__ __forceinline__ void sincos_small(float a, float& sn, float& cs) {
    const double x = (double)a; const double k = __builtin_rint(x * 0.63661977236758134308); const double r = x - k * 1.57079632679489661923;
    const double r2 = r * r;
    const double s = r * (1.0 + r2 * (-1.0 / 6 + r2 * (1.0 / 120 + r2 * (-1.0 / 5040 + r2 * (1.0 / 362880 + r2 * (-1.0 / 39916800 + r2 * (1.0 / 6227020800.0)))))));
    const double c = 1.0 + r2 * (-0.5 + r2 * (1.0 / 24 + r2 * (-1.0 / 720 + r2 * (1.0 / 40320 + r2 * (-1.0 / 3628800 + r2 * (1.0 / 479001600.0 + r2 * (-1.0 / 87178291200.0)))))));
    const int q = ((int)k) & 3;
    const double ss = (q == 0) ? s : (q == 1) ? c : (q == 2) ? -s : -c;
    const double cc = (q == 0) ? c : (q == 1) ? -s : (q == 2) ? -c : s;
    sn = (float)ss; cs = (float)cc;
}

__device__ __forceinline__ void p0_prologue(Frame& F, const Args& A) {
    unsigned char* ws = A.ws;
    float* MOD = (float*)(ws + WS_MOD);
    if (F.vcu < 96) {
        LAS float* SL = (LAS float*)(F.lds);
        LAS float* RED = (LAS float*)(F.lds + 32768);
        const float* c = A.in[1]; const float* cc = A.in[3];
        for (int u = F.tid; u < 5 * 1024; u += NWAVES * 64) { const int i = u >> 10, k = u & 1023; const float v = (i < 4) ? c[i * 1024 + k] : cc[k]; SL[u] = silu_f(v); }
        __syncthreads();
        const float* Wa = A.in[4]; const int n = F.vcu * 64 + F.lane;
        float a0 = 0.f, a1 = 0.f, a2 = 0.f, a3 = 0.f, a4 = 0.f;
        const int kb = F.wave * 128;
#pragma unroll 8
        for (int k = kb; k < kb + 128; ++k) { const float w = Wa[(size_t)k * NMOD + n];
            a0 += SL[k] * w; a1 += SL[1024 + k] * w; a2 += SL[2048 + k] * w; a3 += SL[3072 + k] * w; a4 += SL[4096 + k] * w; }
        LAS float* r = RED + F.wave * 320 + F.lane;
        r[0] = a0; r[64] = a1; r[128] = a2; r[192] = a3; r[256] = a4;
        __syncthreads();
        if (F.tid < 320) { const int i = F.tid >> 6, l = F.tid & 63; float s = 0.f;
#pragma unroll
            for (int w = 0; w < 8; ++w) s += RED[w * 320 + i * 64 + l];
            MOD[i * NMOD + F.vcu * 64 + l] = s + A.in[5][F.vcu * 64 + l]; }
        __syncthreads();
    } else if (F.vcu < 100) {
        const float invf[16] = {1.0f, 0.5623413324356079f, 0.3162277638912201f, 0.17782793939113617f, 0.10000000149011612f, 0.05623413249850273f, 0.03162277489900589f, 0.017782794311642647f,
                                0.009999999776482582f, 0.005623413249850273f, 0.003162277629598975f, 0.0017782794311642647f, 0.0010000000474974513f, 0.000562341301701963f, 0.0003162277571391314f, 0.00017782794020604342f};
        float* ROPE = (float*)(ws + WS_ROPE);
        const int idx = (F.vcu - 96) * 512 + F.tid, pos = idx >> 4, i = idx & 15;
        float fi = invf[0];
#pragma unroll
        for (int j = 1; j < 16; ++j) fi = (i == j) ? invf[j] : fi;
        const float ang = (float)pos * fi; float sn, cs; sincos_small(ang, sn, cs);
        ROPE[idx * 2] = cs; ROPE[idx * 2 + 1] = sn;
    }
    LAS float* scr = (LAS float*)(F.lds + 40960 + F.wave * 8704);
    const int gw = F.vcu * NWAVES + F.wave, NGW = F.G * NWAVES;
    constexpr int I_IN = (D / 64) * (NIN / 32), I_O = (D / 64) * (D / 32), I_1 = (D / 64) * (FF / 32), I_2 = (FF / 64) * (D / 32);
    constexpr int NITEMS = I_IN + I_O + I_1 + I_2;
    bf16* WIN = (bf16*)(ws + WS_WIN); bf16* WOUT = (bf16*)(ws + WS_WOUT); bf16* W1 = (bf16*)(ws + WS_W1); bf16* W2 = (bf16*)(ws + WS_W2);
    for (int it = gw; it < NITEMS; it += NGW) {
        int r = it;
        if (r < I_IN) { p0_transpose_item<true>(A.in[8], D, NIN, WIN, scr, r, F.lane); continue; } r -= I_IN;
        if (r < I_O) { p0_transpose_item<false>(A.in[14], D, D, WOUT, scr, r, F.lane); continue; } r -= I_O;
        if (r < I_1) { p0_transpose_item<false>(A.in[15], D, FF, W1, scr, r, F.lane); continue; } r -= I_1;
        p0_transpose_item<false>(A.in[16], FF, D, W2, scr, r, F.lane);
    }
}

__device__ __forceinline__ void norm_mod_row(Frame& F, const float* xrow, bf16* orow, const float* g, const float* sh, const float* sc) {
    const GAS f32x4* xr = (const GAS f32x4*)xrow + F.lane;
    f32x4 v[4]; float s = 0.f;
#pragma unroll
    for (int j = 0; j < 4; ++j) { v[j] = xr[64 * j]; s += (v[j].x * v[j].x + v[j].y * v[j].y) + (v[j].z * v[j].z + v[j].w * v[j].w); }
    const float rstd = 1.0f / sqrtf(wave_sum(s) * (1.f / D) + EPS);
    GAS unsigned long long* o8 = (GAS unsigned long long*)orow + F.lane;
#pragma unroll
    for (int j = 0; j < 4; ++j) { const f32x4 gv = ((const f32x4*)g)[64 * j + F.lane], shv = ((const f32x4*)sh)[64 * j + F.lane], scv = ((const f32x4*)sc)[64 * j + F.lane];
        const f32x4 y = (v[j] * rstd * gv) * (scv + 1.0f) + shv;
        o8[64 * j] = (unsigned long long)pk2(y.x, y.y) | ((unsigned long long)pk2(y.z, y.w) << 32); }
}
__device__ __forceinline__ void p1_norm(Frame& F, const Args& A) {
    unsigned char* ws = A.ws; const float* MOD = (const float*)(ws + WS_MOD);
    const int gw = F.vcu * NWAVES + F.wave, NGW = F.G * NWAVES;
    bf16* HX = (bf16*)(ws + WS_HX); bf16* HC = (bf16*)(ws + WS_HC);
    for (int m = gw; m < M + MC; m += NGW) {
        if (m < M) { const int b = m >> 13; norm_mod_row(F, A.in[0] + (size_t)m * D, HX + (size_t)m * D, A.in[6], MOD + b * NMOD, MOD + b * NMOD + D); }
        else { const int mc = m - M; norm_mod_row(F, A.in[2] + (size_t)mc * D, HC + (size_t)mc * D, A.in[6], MOD + 4 * NMOD, MOD + 4 * NMOD + D); }
    }
    if (F.vcu == 0) { float* S2 = (float*)(ws + WS_S2);
        for (int u = F.tid; u < 4 * D; u += NWAVES * 64) { const int b = u >> 10, k = u & 1023; S2[u] = A.in[7][k] * (1.0f + MOD[b * NMOD + 4 * D + k]); } }
    const bf16* W1 = (const bf16*)(ws + WS_W1); float* B2 = (float*)(ws + WS_BIAS2);
    for (int n = gw; n < FF; n += NGW) {
        const v4u* wp = (const v4u*)(W1 + (size_t)n * D + 16 * F.lane); const v4u w0 = wp[0], w1 = wp[1];
        float wf[16] = {bf_lo(w0.x), bf_hi(w0.x), bf_lo(w0.y), bf_hi(w0.y), bf_lo(w0.z), bf_hi(w0.z), bf_lo(w0.w), bf_hi(w0.w),
                        bf_lo(w1.x), bf_hi(w1.x), bf_lo(w1.y), bf_hi(w1.y), bf_lo(w1.z), bf_hi(w1.z), bf_lo(w1.w), bf_hi(w1.w)};
#pragma unroll
        for (int b = 0; b < 4; ++b) { const f32x4* sp = (const f32x4*)(MOD + b * NMOD + 3 * D + 16 * F.lane); float s = 0.f;
#pragma unroll
            for (int q = 0; q < 4; ++q) { const f32x4 sv = sp[q]; s += (sv.x * wf[4 * q] + sv.y * wf[4 * q + 1]) + (sv.z * wf[4 * q + 2] + sv.w * wf[4 * q + 3]); }
            s = wave_sum(s); if (F.lane == 0) B2[b * FF + n] = s; }
    }
}

__device__ __forceinline__ float dot8(v4u a, v4u b) {
    return (bf_lo(a.x) * bf_lo(b.x) + bf_hi(a.x) * bf_hi(b.x)) + (bf_lo(a.y) * bf_lo(b.y) + bf_hi(a.y) * bf_hi(b.y)) + (bf_lo(a.z) * bf_lo(b.z) + bf_hi(a.z) * bf_hi(b.z)) + (bf_lo(a.w) * bf_lo(b.w) + bf_hi(a.w) * bf_hi(b.w));
}
__device__ __forceinline__ void p3_attn_naive(Frame& F, const Args& A) {
    unsigned char* ws = A.ws;
    const bf16* QROT = (const bf16*)(ws + WS_QROT); const bf16* Q = (const bf16*)(ws + WS_Q); const bf16* KROT = (const bf16*)(ws + WS_KROT); const bf16* V = (const bf16*)(ws + WS_V);
    const bf16* KC = (const bf16*)(ws + WS_KC); const bf16* VC = (const bf16*)(ws + WS_VC); bf16* MIX = (bf16*)(ws + WS_MIX);
    const float* rpb = A.in[13];
    LAS float* pbuf = (LAS float*)(F.lds) + F.wave * 384;
    const int gw = F.vcu * NWAVES + F.wave, NGW = F.G * NWAVES, lane = F.lane;
    for (int item = gw; item < M * NH; item += NGW) {
        const int row = item >> 3, h = item & 7, b = row >> 13, t = row & 8191, r = t >> 6, c = t & 63;
        const int rs = min(max(r - 4, 0), 120), cs = min(max(c - 8, 0), 48);
        const v4u* qrp = (const v4u*)(QROT + (size_t)row * ATT + h * HD); const v4u* qp = (const v4u*)(Q + (size_t)row * ATT + h * HD);
        float s[6];
#pragma unroll
        for (int j = 0; j < 2; ++j) { const int w = lane + 64 * j, i = w >> 4, jc = w & 15; const size_t kt = (size_t)b * SEQ + (rs + i) * 64 + cs + jc;
            const v4u* kp = (const v4u*)(KROT + kt * ATT + h * HD); float d = 0.f;
#pragma unroll
            for (int e = 0; e < 8; ++e) d += dot8(qrp[e], kp[e]);
            s[j] = d + rpb[h * 465 + (rs + i - r + 7) * 31 + (cs + jc - c + 15)] * LOG2E; }
#pragma unroll
        for (int j = 0; j < 4; ++j) { const int ci = lane + 64 * j; const v4u* kp = (const v4u*)(KC + (size_t)(b * CTXL + ci) * ATT + h * HD); float d = 0.f;
#pragma unroll
            for (int e = 0; e < 8; ++e) d += dot8(qp[e], kp[e]);
            s[2 + j] = d; }
        float mx = fmaxf(fmaxf(fmaxf(s[0], s[1]), fmaxf(s[2], s[3])), fmaxf(s[4], s[5])); mx = wave_max(mx);
        float l = 0.f;
#pragma unroll
        for (int j = 0; j < 6; ++j) { s[j] = __builtin_amdgcn_exp2f(s[j] - mx); l += s[j]; pbuf[lane + 64 * j] = s[j]; }
        l = wave_sum(l);
        LDS_WAIT(); asm volatile("" ::: "memory");
        float o = 0.f;
#pragma unroll 8
        for (int w = 0; w < 128; ++w) { const int i = w >> 4, jc = w & 15; const size_t kt = (size_t)b * SEQ + (rs + i) * 64 + cs + jc; o += pbuf[w] * bf1(V[kt * ATT + h * HD + lane]); }
#pragma unroll 8
        for (int ci = 0; ci < CTXL; ++ci) o += pbuf[128 + ci] * bf1(VC[(size_t)(b * CTXL + ci) * ATT + h * HD + lane]);
        MIX[(size_t)row * D + h * HD + lane] = (bf16)f2bf(o / l);
        LDS_WAIT(); asm volatile("" ::: "memory");
    }
}
__device__ __forceinline__ void p3_conv_naive(Frame& F, const Args& A) {
    unsigned char* ws = A.ws; const bf16* HG = (const bf16*)(ws + WS_HG); bf16* MIX = (bf16*)(ws + WS_MIX);
    const float* dwk = A.in[9]; const float* dwb = A.in[10]; const float* lg = A.in[11]; const float* lb = A.in[12];
    const int gw = F.vcu * NWAVES + F.wave, NGW = F.G * NWAVES, c0 = F.lane * 8;
    for (int row = gw; row < M; row += NGW) {
        const int b = row >> 13, t = row & 8191;
        const f32x4 b0 = *(const f32x4*)(dwb + c0), b1 = *(const f32x4*)(dwb + c0 + 4);
        float a[8] = {b0.x, b0.y, b0.z, b0.w, b1.x, b1.y, b1.z, b1.w};
        for (int j = 0; j < CW; ++j) { const int tt = t + j - 15; if (tt < 0 || tt >= SEQ) continue;
            const v4u hv = *(const v4u*)(HG + (size_t)(b * SEQ + tt) * CONVD + c0); const f32x4 k0 = *(const f32x4*)(dwk + j * CONVD + c0), k1 = *(const f32x4*)(dwk + j * CONVD + c0 + 4);
            a[0] += bf_lo(hv.x) * k0.x; a[1] += bf_hi(hv.x) * k0.y; a[2] += bf_lo(hv.y) * k0.z; a[3] += bf_hi(hv.y) * k0.w;
            a[4] += bf_lo(hv.z) * k1.x; a[5] += bf_hi(hv.z) * k1.y; a[6] += bf_lo(hv.w) * k1.z; a[7] += bf_hi(hv.w) * k1.w; }
        float s = 0.f;
#pragma unroll
        for (int e = 0; e < 8; ++e) s += a[e];
        const float mean = wave_sum(s) * (1.f / CONVD); float q = 0.f;
#pragma unroll
        for (int e = 0; e < 8; ++e) { a[e] -= mean; q += a[e] * a[e]; }
        const float rstd = 1.0f / sqrtf(wave_sum(q) * (1.f / CONVD) + EPS);
        const f32x4 g0 = *(const f32x4*)(lg + c0), g1 = *(const f32x4*)(lg + c0 + 4), e0 = *(const f32x4*)(lb + c0), e1 = *(const f32x4*)(lb + c0 + 4);
        const float gg[8] = {g0.x, g0.y, g0.z, g0.w, g1.x, g1.y, g1.z, g1.w}, bb[8] = {e0.x, e0.y, e0.z, e0.w, e1.x, e1.y, e1.z, e1.w};
        float y[8];
#pragma unroll
        for (int e = 0; e < 8; ++e) { const float v = a[e] * rstd * gg[e] + bb[e]; y[e] = silu_f(v); }
        v4u o; o.x = pk2(y[0], y[1]); o.y = pk2(y[2], y[3]); o.z = pk2(y[4], y[5]); o.w = pk2(y[6], y[7]);
        *(GAS v4u*)(MIX + (size_t)row * D + ATT + c0) = o;
    }
}

__device__ __forceinline__ void p7_final(Frame& F, const Args& A) {
    const float* SSQ2 = (const float*)(A.ws + WS_SSQ2); const float* fg = A.in[17];
    const int gw = F.vcu * NWAVES + F.wave, NGW = F.G * NWAVES;
    for (int m = gw; m < M; m += NGW) {
        const float pv = (F.lane < 16) ? SSQ2[(size_t)m * 16 + F.lane] : 0.f;
        const float rstd = 1.0f / sqrtf(wave_sum(pv) * (1.f / D) + EPS);
        GAS f32x4* xr = (GAS f32x4*)(A.out + (size_t)m * D) + F.lane;
#pragma unroll
        for (int j = 0; j < 4; ++j) { const f32x4 gv = ((const f32x4*)fg)[64 * j + F.lane]; xr[64 * j] = xr[64 * j] * rstd * gv; }
    }
}

__global__ void __launch_bounds__(NWAVES * 64, 2) hymba_fwd(Args args) {
    extern __shared__ __attribute__((aligned(16))) unsigned char lds[];
    Frame F;
    F.lds = (LAS unsigned char*)lds;
    F.MISC = (volatile LAS unsigned*)(F.lds + MISC_OFF);
    F.tid = threadIdx.x; F.lane = F.tid & 63; F.wave = __builtin_amdgcn_readfirstlane(F.tid >> 6);
    F.G = gridDim.x; { const int bx = blockIdx.x; F.vcu = (F.G % 8 == 0) ? (bx % 8) * (F.G / 8) + bx / 8 : bx; }
    unsigned char* ws = args.ws;
    F.ctl = (gu32*)(ws + WS_CTL);
    for (int u = F.tid; u < (LDS_BYTES - LDSCTL_OFF) / 4; u += NWAVES * 64) ((LAS unsigned*)(F.lds + LDSCTL_OFF))[u] = 0u;
    __syncthreads();
    const int lo = args.ph_lo, hi = args.ph_hi;
    XcdBarrier bar; bar.bar = (unsigned*)(F.ctl + CW_BAR); bar.x = 0; bar.st = nullptr;
    if (hi - lo > 1) bar = xcd_barrier_post((unsigned*)(F.ctl + CW_BAR), F.MISC + 8);
#define IN(k) (lo <= (k) && (k) < hi)
#define SEAM(k) do { if (IN(k) && IN((k) + 1)) xcd_barrier(bar); } while (0)

    if (IN(0)) { p0_prologue(F, args); SEAM(0); }
    if (IN(1)) { p1_norm(F, args); SEAM(1); }
    if (IN(2)) {
        { pg8::Gemm g{(const pg8::bf16_t*)(ws + WS_HX), (const pg8::bf16_t*)(ws + WS_WIN), M, NIN, D}; pg8::StaticOrder S; S.init(M, NIN, F.G, (int)blockIdx.x);
          pg8::EpiInProj E{(pg8::bf16_t*)(ws + WS_Q), (pg8::bf16_t*)(ws + WS_QROT), (pg8::bf16_t*)(ws + WS_KROT), (pg8::bf16_t*)(ws + WS_V), (pg8::bf16_t*)(ws + WS_HG), (const float*)(ws + WS_ROPE)};
          pg8::gemm_phase<pg8::EpiInProj, pg8::StaticOrder, true, true>(F.lds + RING_OFF, g, S, E); }
        { pg8::Gemm g{(const pg8::bf16_t*)(ws + WS_HC), (const pg8::bf16_t*)(ws + WS_WIN) + (size_t)512 * D, MC, 1024, D}; pg8::StaticOrder S; S.init(MC, 1024, F.G, (int)blockIdx.x);
          pg8::EpiCtx E{(pg8::bf16_t*)(ws + WS_KC), (pg8::bf16_t*)(ws + WS_VC)};
          pg8::gemm_phase<pg8::EpiCtx, pg8::StaticOrder, true, true>(F.lds + RING_OFF, g, S, E); }
        SEAM(2);
    }
    if (IN(3)) { p3_attn_naive(F, args); p3_conv_naive(F, args); SEAM(3); }
    if (IN(4)) {
        pg8::Gemm g{(const pg8::bf16_t*)(ws + WS_MIX), (const pg8::bf16_t*)(ws + WS_WOUT), M, D, D}; pg8::StaticOrder S; S.init(M, D, F.G, (int)blockIdx.x);
        pg8::EpiOutProj E{args.in[0], args.out, (pg8::bf16_t*)(ws + WS_XS), (float*)(ws + WS_SSQ), (const float*)(ws + WS_MOD), (const float*)(ws + WS_S2)};
        pg8::gemm_phase<pg8::EpiOutProj, pg8::StaticOrder, true, true>(F.lds + RING_OFF, g, S, E);
        SEAM(4);
    }
    if (IN(5)) {
        pg8::Gemm g{(const pg8::bf16_t*)(ws + WS_XS), (const pg8::bf16_t*)(ws + WS_W1), M, FF, D}; pg8::StaticOrder S; S.init(M, FF, F.G, (int)blockIdx.x);
        pg8::EpiMlp1 E{(pg8::bf16_t*)(ws + WS_HID), (const float*)(ws + WS_SSQ), (const float*)(ws + WS_BIAS2), EPS};
        pg8::gemm_phase<pg8::EpiMlp1, pg8::StaticOrder, true, true>(F.lds + RING_OFF, g, S, E);
        SEAM(5);
    }
    if (IN(6)) {
        pg8::Gemm g{(const pg8::bf16_t*)(ws + WS_HID), (const pg8::bf16_t*)(ws + WS_W2), M, D, FF}; pg8::StaticOrder S; S.init(M, D, F.G, (int)blockIdx.x);
        pg8::EpiMlp2 E{args.out, (float*)(ws + WS_SSQ2), (const float*)(ws + WS_MOD)};
        pg8::gemm_phase<pg8::EpiMlp2, pg8::StaticOrder, true, true>(F.lds + RING_OFF, g, S, E);
        SEAM(6);
    }
    if (IN(7)) { p7_final(F, args); }
#undef IN
#undef SEAM
}

extern "C" void kernel_launch(void* const* d_in, const int* in_sizes, int n_in, void* d_out, int out_size, void* d_ws, size_t ws_size, hipStream_t stream) {
    static int grid = 0;
    if (grid == 0) {
        if (n_in != 18 || in_sizes[0] != M * D || out_size != M * D || ws_size < WS_END) { fprintf(stderr, "kernel_launch: unexpected shapes (n_in %d, in0 %d, out %d, ws %zu)\n", n_in, n_in > 0 ? in_sizes[0] : -1, out_size, ws_size); grid = -1; return; }
        int dev = 0, cus = 0, per_cu = 0;
        if (hipGetDevice(&dev) != hipSuccess || hipDeviceGetAttribute(&cus, hipDeviceAttributeMultiprocessorCount, dev) != hipSuccess) { grid = -1; return; }
        if (hipFuncSetAttribute((const void*)hymba_fwd, hipFuncAttributeMaxDynamicSharedMemorySize, LDS_BYTES) != hipSuccess) { fprintf(stderr, "kernel_launch: hipFuncSetAttribute failed\n"); grid = -1; return; }
        if (hipOccupancyMaxActiveBlocksPerMultiprocessor(&per_cu, (const void*)hymba_fwd, NWAVES * 64, LDS_BYTES) != hipSuccess || per_cu < 1) { fprintf(stderr, "kernel_launch: occupancy query says %d\n", per_cu); per_cu = 1; }
        (void)hipGetLastError();
        grid = cus;
    }
    if (grid < 0) return;
    if (hipMemsetAsync((char*)d_ws + WS_CTL, 0, CTL_ZERO_BYTES, stream) != hipSuccess) return;
    Args a{};
    for (int i = 0; i < 18; ++i) a.in[i] = (const float*)d_in[i];
    a.out = (float*)d_out; a.ws = (unsigned char*)d_ws;
#if MK_N_LAUNCHES == 1
    a.ph_lo = 0; a.ph_hi = N_PHASES;
    hipLaunchKernelGGL(hymba_fwd, dim3(grid), dim3(NWAVES * 64), LDS_BYTES, stream, a);
#else
    for (int p = 0; p < N_PHASES; ++p) { a.ph_lo = p; a.ph_hi = p + 1; hipLaunchKernelGGL(hymba_fwd, dim3(grid), dim3(NWAVES * 64), LDS_BYTES, stream, a); }
#endif
}
```

```cpp
#include <hip/hip_runtime.h>
#include <cstdio>
#include <cstdint>
namespace pg8 {
#define PG8_LAS __attribute__((address_space(3)))
typedef unsigned short bf16_t;
typedef short bf16x8 __attribute__((ext_vector_type(8)));
typedef float f32x4 __attribute__((ext_vector_type(4)));
typedef unsigned u32x4 __attribute__((ext_vector_type(4)));
constexpr int BM = 256, BK = 64, HALF = 128, HTB = HALF * BK * 2  , STAGE_BYTES = 8 * HTB, NXCD = 8, WGM = 8;

__host__ __device__ __forceinline__ int lds_byte(int r, int c) { const int st = (r >> 4) * 2 + (c >> 5), rr = r & 15, cc = c & 31, ob = rr * 64 + cc * 2; return st * 1024 + (ob ^ (((ob >> 9) & 1) << 5)); }
__host__ __device__ __forceinline__ void stage_rc(int b, int& R, int& C) { const int st = b / 1024, sb = b % 1024, swz = sb ^ (((sb >> 9) & 1) << 5); R = (st >> 1) * 16 + swz / 64; C = (st & 1) * 32 + (swz % 64) / 2; }
__host__ __device__ __forceinline__ int perm32(int rho) { const int n = rho >> 4, i = rho & 15; return 8 * (i >> 2) + 4 * n + (i & 3); }

struct Unit { int pm, pn; };
struct Gemm { const bf16_t* A; const bf16_t* Bt; int M, N, K; };

struct StaticOrder {
    int nM, nN, nwg, G, c;
    __host__ __device__ void init(int M, int N, int G_, int c_) { nM = M / BM; nN = N / BM; nwg = nM * nN; G = G_; c = c_; }
    __host__ __device__ bool next(int i, Unit& u) const {
        const long L = (long)i * G + c; if (L >= nwg) return false;
        int wgid = (int)L; { const int q = nwg / NXCD, r = nwg % NXCD, xcd = wgid % NXCD, off = wgid / NXCD; wgid = (xcd < r ? xcd * (q + 1) : r * (q + 1) + (xcd - r) * q) + off; }
        const int nig = WGM * nN, gid = wgid / nig, fm = gid * WGM, gsz = (nM - fm) < WGM ? (nM - fm) : WGM;
        u.pm = fm + ((wgid % nig) % gsz); u.pn = (wgid % nig) / gsz; return true;
    }
    __device__ __forceinline__ void a_ready(const Unit&) const {}
    __device__ __forceinline__ void done(const Unit&) const {}
};


typedef float f32x2 __attribute__((ext_vector_type(2)));
typedef __bf16 bf16x2_t __attribute__((ext_vector_type(2)));
typedef unsigned u32x2 __attribute__((ext_vector_type(2)));
__device__ __forceinline__ unsigned cvt_pk_bf16(float lo, float hi) { f32x2 v = {lo, hi}; bf16x2_t b = __builtin_convertvector(v, bf16x2_t); return __builtin_bit_cast(unsigned, b); }
__device__ __forceinline__ u32x4 pack8(f32x4 a, f32x4 b) { u32x4 w; w.x = cvt_pk_bf16(a[0], a[1]); w.y = cvt_pk_bf16(a[2], a[3]); w.z = cvt_pk_bf16(b[0], b[1]); w.w = cvt_pk_bf16(b[2], b[3]); return w; }
constexpr float QSCALE = 0.125f * 1.4426950408889634f;
constexpr int SEQ_L = 8192, GRID_WL = 64;

struct EpiInProj {
    static constexpr bool PERM = true, AFTER_DRAIN = false;
    bf16_t *Q, *QROT, *KROT, *V, *HG; const float* rope;
    __device__ __forceinline__ void operator()(const f32x4 (&acc)[2][2][4][2], const Unit& u, int wr, int wc, int fr, int fq) const {
        const int row0 = u.pm * BM + wr * 64 + fr; const int pn = u.pn;
        if (pn < 4) {
            const int cb = (pn & 1) * 256 + wc * 32 + 8 * fq; const int axis = wc & 1;
#pragma unroll
            for (int ai = 0; ai < 2; ++ai)
#pragma unroll
                for (int m = 0; m < 4; ++m) {
                    const int row = row0 + ai * HALF + m * 16, tok = row & (SEQ_L - 1), pos = axis ? (tok & (GRID_WL - 1)) : (tok >> 6);
                    const f32x4* rp = (const f32x4*)(rope + (pos * 16 + 4 * fq) * 2); const f32x4 cs0 = rp[0], cs1 = rp[1];
                    const f32x4 c = {cs0[0], cs0[2], cs1[0], cs1[2]}, s = {cs0[1], cs0[3], cs1[1], cs1[3]};
#pragma unroll
                    for (int bj = 0; bj < 2; ++bj) {
                        const f32x4 x1 = acc[ai][bj][m][0], x2 = acc[ai][bj][m][1];
                        const f32x4 r1 = x1 * c - x2 * s, r2 = x2 * c + x1 * s;
                        const size_t off = (size_t)row * 512 + cb + bj * HALF;
                        if (pn < 2) { *(u32x4*)(Q + off) = pack8(x1 * QSCALE, x2 * QSCALE); *(u32x4*)(QROT + off) = pack8(r1 * QSCALE, r2 * QSCALE); }
                        else *(u32x4*)(KROT + off) = pack8(r1, r2);
                    }
                }
        } else if (pn < 6) {
            const int cb = (pn & 1) * 256 + wc * 32 + 8 * fq;
#pragma unroll
            for (int ai = 0; ai < 2; ++ai)
#pragma unroll
                for (int m = 0; m < 4; ++m) { const int row = row0 + ai * HALF + m * 16;
#pragma unroll
                    for (int bj = 0; bj < 2; ++bj) *(u32x4*)(V + (size_t)row * 512 + cb + bj * HALF) = pack8(acc[ai][bj][m][0], acc[ai][bj][m][1]); }
        } else {
            const int cb = (pn - 6) * 128 + wc * 32 + 8 * fq;
#pragma unroll
            for (int ai = 0; ai < 2; ++ai)
#pragma unroll
                for (int m = 0; m < 4; ++m) { const int row = row0 + ai * HALF + m * 16; f32x4 h[2];
#pragma unroll
                    for (int n = 0; n < 2; ++n) { const f32x4 a = acc[ai][0][m][n], b = acc[ai][1][m][n];
#pragma unroll
                        for (int e = 0; e < 4; ++e) h[n][e] = a[e] * __builtin_amdgcn_rcpf(1.0f + __builtin_amdgcn_exp2f(-1.4426950408889634f * b[e])); }
                    *(u32x4*)(HG + (size_t)row * 512 + cb) = pack8(h[0], h[1]); }
        }
    }
};
struct EpiCtx {
    static constexpr bool PERM = true, AFTER_DRAIN = false;
    bf16_t *KC, *VC;
    __device__ __forceinline__ void operator()(const f32x4 (&acc)[2][2][4][2], const Unit& u, int wr, int wc, int fr, int fq) const {
        const int row0 = u.pm * BM + wr * 64 + fr; bf16_t* O = u.pn < 2 ? KC : VC; const int cb = (u.pn & 1) * 256 + wc * 32 + 8 * fq;
#pragma unroll
        for (int ai = 0; ai < 2; ++ai)
#pragma unroll
            for (int m = 0; m < 4; ++m) { const int row = row0 + ai * HALF + m * 16;
#pragma unroll
                for (int bj = 0; bj < 2; ++bj) *(u32x4*)(O + (size_t)row * 512 + cb + bj * HALF) = pack8(acc[ai][bj][m][0], acc[ai][bj][m][1]); }
    }
};
struct EpiOutProj {
    static constexpr bool PERM = false, AFTER_DRAIN = false;
    const float* X; float* XN; bf16_t* XS; float* SSQ; const float* mod; const float* S2;
    __device__ __forceinline__ void operator()(const f32x4 (&acc)[2][2][4][2], const Unit& u, int wr, int wc, int fr, int fq) const {
        const int row0 = u.pm * BM + wr * 64 + fr, col0 = u.pn * BM + wc * 32 + 4 * fq; const int b = (u.pm * BM) >> 13;
        f32x4 g1[2][2], s2[2][2];
#pragma unroll
        for (int bj = 0; bj < 2; ++bj)
#pragma unroll
            for (int n = 0; n < 2; ++n) { g1[bj][n] = *(const f32x4*)(mod + b * 6144 + 2048 + col0 + bj * HALF + n * 16); s2[bj][n] = *(const f32x4*)(S2 + b * 1024 + col0 + bj * HALF + n * 16); }
#pragma unroll
        for (int ai = 0; ai < 2; ++ai)
#pragma unroll
            for (int m = 0; m < 4; ++m) { const int row = row0 + ai * HALF + m * 16; const size_t off = (size_t)row * 1024 + col0; float q = 0.f;
#pragma unroll
                for (int bj = 0; bj < 2; ++bj)
#pragma unroll
                    for (int n = 0; n < 2; ++n) { const f32x4 xv = *(const f32x4*)(X + off + bj * HALF + n * 16); const f32x4 xn = xv + g1[bj][n] * acc[ai][bj][m][n];
                        *(f32x4*)(XN + off + bj * HALF + n * 16) = xn; q += (xn[0] * xn[0] + xn[1] * xn[1]) + (xn[2] * xn[2] + xn[3] * xn[3]);
                        const f32x4 xs = xn * s2[bj][n]; u32x2 w; w.x = cvt_pk_bf16(xs[0], xs[1]); w.y = cvt_pk_bf16(xs[2], xs[3]); *(u32x2*)(XS + off + bj * HALF + n * 16) = w; }
                q += __shfl_xor(q, 16); q += __shfl_xor(q, 32);
                if (fq == 0) SSQ[(size_t)row * 16 + u.pn * 4 + wc] = q; }
    }
};
struct EpiMlp1 {
    static constexpr bool PERM = true, AFTER_DRAIN = false;
    bf16_t* HID; const float* SSQ; const float* BIAS2; float eps;
    __device__ __forceinline__ void operator()(const f32x4 (&acc)[2][2][4][2], const Unit& u, int wr, int wc, int fr, int fq) const {
        const int row0 = u.pm * BM + wr * 64 + fr, col0 = u.pn * BM + wc * 32 + 8 * fq; const int b = (u.pm * BM) >> 13;
        f32x4 bv[2][2];
#pragma unroll
        for (int bj = 0; bj < 2; ++bj)
#pragma unroll
            for (int n = 0; n < 2; ++n) bv[bj][n] = *(const f32x4*)(BIAS2 + b * 4096 + col0 + bj * HALF + 4 * n);
#pragma unroll
        for (int ai = 0; ai < 2; ++ai)
#pragma unroll
            for (int m = 0; m < 4; ++m) { const int row = row0 + ai * HALF + m * 16; const f32x4* sp = (const f32x4*)(SSQ + (size_t)row * 16);
                const f32x4 s0 = sp[0], s1 = sp[1], s2 = sp[2], s3 = sp[3];
                const float ss = ((s0[0] + s0[1]) + (s0[2] + s0[3])) + ((s1[0] + s1[1]) + (s1[2] + s1[3])) + ((s2[0] + s2[1]) + (s2[2] + s2[3])) + ((s3[0] + s3[1]) + (s3[2] + s3[3]));
                const float rstd = 1.0f / sqrtf(ss * (1.0f / 1024.0f) + eps);
#pragma unroll
                for (int bj = 0; bj < 2; ++bj) { f32x4 v0 = acc[ai][bj][m][0] * rstd + bv[bj][0], v1 = acc[ai][bj][m][1] * rstd + bv[bj][1];
#pragma unroll
                    for (int e = 0; e < 4; ++e) { const float a0 = fmaxf(v0[e], 0.f), a1 = fmaxf(v1[e], 0.f); v0[e] = a0 * a0; v1[e] = a1 * a1; }
                    *(u32x4*)(HID + (size_t)row * 4096 + col0 + bj * HALF) = pack8(v0, v1); } }
    }
};
struct EpiMlp2 {
    static constexpr bool PERM = false, AFTER_DRAIN = false;
    float* Y; float* SSQ; const float* mod;
    __device__ __forceinline__ void operator()(const f32x4 (&acc)[2][2][4][2], const Unit& u, int wr, int wc, int fr, int fq) const {
        const int row0 = u.pm * BM + wr * 64 + fr, col0 = u.pn * BM + wc * 32 + 4 * fq; const int b = (u.pm * BM) >> 13;
        f32x4 g2[2][2];
#pragma unroll
        for (int bj = 0; bj < 2; ++bj)
#pragma unroll
            for (int n = 0; n < 2; ++n) g2[bj][n] = *(const f32x4*)(mod + b * 6144 + 5120 + col0 + bj * HALF + n * 16);
#pragma unroll
        for (int ai = 0; ai < 2; ++ai)
#pragma unroll
            for (int m = 0; m < 4; ++m) { const int row = row0 + ai * HALF + m * 16; const size_t off = (size_t)row * 1024 + col0; float q = 0.f;
#pragma unroll
                for (int bj = 0; bj < 2; ++bj)
#pragma unroll
                    for (int n = 0; n < 2; ++n) { const f32x4 xv = *(const f32x4*)(Y + off + bj * HALF + n * 16); const f32x4 y = xv + g2[bj][n] * acc[ai][bj][m][n];
                        *(f32x4*)(Y + off + bj * HALF + n * 16) = y; q += (y[0] * y[0] + y[1] * y[1]) + (y[2] * y[2] + y[3] * y[3]); }
                q += __shfl_xor(q, 16); q += __shfl_xor(q, 32);
                if (fq == 0) SSQ[(size_t)row * 16 + u.pn * 4 + wc] = q; }
    }
};

template <class Epi, class Sched, bool ALIGN_EPI = false, bool SP2 = false>
__device__ __forceinline__ void gemm_phase(PG8_LAS unsigned char* lds, const Gemm g, const Sched& S, const Epi& E) {
    const int tid = threadIdx.x, wid = __builtin_amdgcn_readfirstlane(tid >> 6), lane = tid & 63, wr = wid >> 2, wc = wid & 3, fr = lane & 15, fq = lane >> 4;
    const int K = g.K, nt = K / BK;
    unsigned voffA[2], voffB[2];
#pragma unroll
    for (int i = 0; i < 2; ++i) { int R, C; stage_rc(tid * 16 + i * 8192, R, C); const int Rb = Epi::PERM ? ((R & ~31) + perm32(R & 31)) : R;
        voffA[i] = (unsigned)(R * K + C) * 2u; voffB[i] = (unsigned)(Rb * K + C) * 2u; }
    const size_t kstep = (size_t)(BK * 2);
    const size_t hstep = (size_t)HALF * K * 2;
    const size_t tstep = 2 * hstep;
    const unsigned ldsw = (unsigned)wid * 1024u;
    const int aoff = lds_byte(wr * 64 + fr, fq * 8), boff = lds_byte(wc * 32 + fr, fq * 8);
#define PG8_SA(b, h) (((b) * 2 + (h)) * HTB)
#define PG8_SB(b, h) ((4 + (b) * 2 + (h)) * HTB)
#define PG8_STAGE(bufoff, gbase, voff) do { _Pragma("unroll") for (int _i = 0; _i < 2; ++_i) \
        __builtin_amdgcn_global_load_lds((const unsigned*)((const char*)(gbase) + (voff)[_i]), (PG8_LAS unsigned*)(lds + (bufoff) + ldsw + _i * 8192), 16, 0, 0); } while (0)
#define PG8_LDA(dst, b, h) do { _Pragma("unroll") for (int m = 0; m < 4; ++m) _Pragma("unroll") for (int k = 0; k < 2; ++k) dst[m][k] = *(const PG8_LAS bf16x8*)(lds + PG8_SA(b, h) + aoff + m * 2048 + k * 1024); } while (0)
#define PG8_LDB(dst, b, h) do { _Pragma("unroll") for (int n = 0; n < 2; ++n) _Pragma("unroll") for (int k = 0; k < 2; ++k) dst[n][k] = *(const PG8_LAS bf16x8*)(lds + PG8_SB(b, h) + boff + n * 2048 + k * 1024); } while (0)
#define PG8_MMA(ai, bj, At, Bt) do { __builtin_amdgcn_s_setprio(1); _Pragma("unroll") for (int m = 0; m < 4; ++m) _Pragma("unroll") for (int n = 0; n < 2; ++n) _Pragma("unroll") for (int k = 0; k < 2; ++k) \
        acc[ai][bj][m][n] = __builtin_amdgcn_mfma_f32_16x16x32_bf16(Bt[n][k], At[m][k], acc[ai][bj][m][n], 0, 0, 0); __builtin_amdgcn_s_setprio(0); } while (0)
#define PG8_WAIT_V(n) asm volatile("s_waitcnt vmcnt(" #n ")" ::: "memory")
#define PG8_WAIT_L(n) asm volatile("s_waitcnt lgkmcnt(" #n ")" ::: "memory")
#define PG8_BAR __builtin_amdgcn_s_barrier()
#define PG8_SCHED __builtin_amdgcn_sched_barrier(0)
    Unit cur, nxt; int ui = 0;
    if (!S.next(0, cur)) return;
    f32x4 acc[2][2][4][2];
#pragma unroll
    for (int a = 0; a < 2; ++a)
#pragma unroll
        for (int b = 0; b < 2; ++b)
#pragma unroll
            for (int m = 0; m < 4; ++m)
#pragma unroll
                for (int n = 0; n < 2; ++n) acc[a][b][m][n] = (f32x4){0.f, 0.f, 0.f, 0.f};
    bf16x8 At[4][2], B0[2][2], B1[2][2];
    const char* cA = (const char*)g.A + (size_t)cur.pm * tstep; const char* cB = (const char*)g.Bt + (size_t)cur.pn * tstep;
    S.a_ready(cur);
    if constexpr (SP2) {
        PG8_STAGE(PG8_SB(0, 0), cB, voffB); PG8_STAGE(PG8_SB(0, 1), cB + hstep, voffB); PG8_STAGE(PG8_SA(0, 0), cA, voffA); PG8_STAGE(PG8_SA(0, 1), cA + hstep, voffA);
        if (wr == 1) PG8_BAR;
        PG8_WAIT_V(2); PG8_BAR;
        PG8_STAGE(PG8_SB(1, 0), cB + kstep, voffB); PG8_STAGE(PG8_SA(1, 0), cA + kstep, voffA); PG8_STAGE(PG8_SB(1, 1), cB + hstep + kstep, voffB);
        PG8_WAIT_V(6); PG8_BAR;
    } else {
        PG8_STAGE(PG8_SB(0, 0), cB, voffB); PG8_STAGE(PG8_SA(0, 0), cA, voffA); PG8_STAGE(PG8_SB(0, 1), cB + hstep, voffB); PG8_STAGE(PG8_SA(0, 1), cA + hstep, voffA);
        if (wr == 1) PG8_BAR;
        PG8_WAIT_V(4); PG8_BAR;
        PG8_STAGE(PG8_SB(1, 0), cB + kstep, voffB); PG8_STAGE(PG8_SA(1, 0), cA + kstep, voffA); PG8_STAGE(PG8_SB(1, 1), cB + hstep + kstep, voffB);
        PG8_WAIT_V(6); PG8_BAR;
    }
    for (;;) {
        const bool has_next = S.next(ui + 1, nxt);
        const char* nA = has_next ? (const char*)g.A + (size_t)nxt.pm * tstep : cA; const char* nB = has_next ? (const char*)g.Bt + (size_t)nxt.pn * tstep : cB;
        for (int t = 0; t < nt; t += 2) {
            const bool last = (t == nt - 2);
            const char* a1 = cA + (size_t)(t + 1) * kstep;
            const char* a2 = last ? nA : cA + (size_t)(t + 2) * kstep; const char* b2 = last ? nB : cB + (size_t)(t + 2) * kstep;
            const char* a3 = a2 + kstep; const char* b3 = b2 + kstep;
            if (last && has_next) S.a_ready(nxt);
            if constexpr (SP2) {
            PG8_LDB(B0, 0, 0); PG8_LDB(B1, 0, 1); PG8_SCHED; PG8_LDA(At, 0, 0); PG8_STAGE(PG8_SA(1, 1), a1 + hstep, voffA);
            PG8_WAIT_V(8); PG8_WAIT_L(0); PG8_BAR; PG8_MMA(0, 0, At, B0); PG8_MMA(0, 1, At, B1); PG8_BAR; PG8_SCHED;
            PG8_LDA(At, 0, 1); PG8_STAGE(PG8_SB(0, 0), b2, voffB); PG8_STAGE(PG8_SB(0, 1), b2 + hstep, voffB); PG8_STAGE(PG8_SA(0, 0), a2, voffA);
            PG8_WAIT_V(8); PG8_WAIT_L(0); PG8_BAR; PG8_MMA(1, 0, At, B0); PG8_MMA(1, 1, At, B1); PG8_BAR; PG8_SCHED;
            PG8_LDB(B0, 1, 0); PG8_LDB(B1, 1, 1); PG8_SCHED; PG8_LDA(At, 1, 0); PG8_STAGE(PG8_SA(0, 1), a2 + hstep, voffA);
            PG8_WAIT_V(8); PG8_WAIT_L(0); PG8_BAR; PG8_MMA(0, 0, At, B0); PG8_MMA(0, 1, At, B1); PG8_BAR; PG8_SCHED;
            PG8_LDA(At, 1, 1); PG8_STAGE(PG8_SB(1, 0), b3, voffB); PG8_STAGE(PG8_SB(1, 1), b3 + hstep, voffB); PG8_STAGE(PG8_SA(1, 0), a3, voffA);
            PG8_WAIT_V(8); PG8_WAIT_L(0); PG8_BAR; PG8_MMA(1, 0, At, B0); PG8_MMA(1, 1, At, B1); PG8_BAR; PG8_SCHED;
            } else {
            PG8_LDB(B0, 0, 0); PG8_SCHED; PG8_LDA(At, 0, 0); PG8_STAGE(PG8_SA(1, 1), a1 + hstep, voffA);
            PG8_WAIT_L(8); PG8_BAR; PG8_WAIT_L(0); PG8_MMA(0, 0, At, B0); PG8_BAR; PG8_SCHED;
            PG8_LDB(B1, 0, 1); PG8_STAGE(PG8_SB(0, 0), b2, voffB);
            PG8_BAR; PG8_WAIT_L(0); PG8_MMA(0, 1, At, B1); PG8_BAR;
            PG8_LDA(At, 0, 1); PG8_STAGE(PG8_SA(0, 0), a2, voffA);
            PG8_BAR; PG8_WAIT_L(0); PG8_MMA(1, 0, At, B0); PG8_BAR; PG8_SCHED;
            PG8_STAGE(PG8_SB(0, 1), b2 + hstep, voffB);
            PG8_WAIT_V(6); PG8_BAR; PG8_MMA(1, 1, At, B1); PG8_BAR;
            PG8_LDB(B0, 1, 0); PG8_SCHED; PG8_LDA(At, 1, 0); PG8_STAGE(PG8_SA(0, 1), a2 + hstep, voffA);
            PG8_WAIT_L(8); PG8_BAR; PG8_WAIT_L(0); PG8_MMA(0, 0, At, B0); PG8_BAR; PG8_SCHED;
            PG8_LDB(B1, 1, 1); PG8_STAGE(PG8_SB(1, 0), b3, voffB);
            PG8_BAR; PG8_WAIT_L(0); PG8_MMA(0, 1, At, B1); PG8_BAR;
            PG8_LDA(At, 1, 1); PG8_STAGE(PG8_SA(1, 0), a3, voffA);
            PG8_BAR; PG8_WAIT_L(0); PG8_MMA(1, 0, At, B0); PG8_BAR; PG8_SCHED;
            PG8_STAGE(PG8_SB(1, 1), b3 + hstep, voffB);
            PG8_WAIT_V(6); PG8_BAR; PG8_MMA(1, 1, At, B1); PG8_BAR;
            }
        }
        if constexpr (ALIGN_EPI) { if (wr == 0) PG8_BAR; }
        if constexpr (!Epi::AFTER_DRAIN) { E(acc, cur, wr, wc, fr, fq); S.done(cur); }
        if (!has_next) break;
#pragma unroll
        for (int a = 0; a < 2; ++a)
#pragma unroll
            for (int b = 0; b < 2; ++b)
#pragma unroll
                for (int m = 0; m < 4; ++m)
#pragma unroll
                    for (int n = 0; n < 2; ++n) acc[a][b][m][n] = (f32x4){0.f, 0.f, 0.f, 0.f};
        cur = nxt; cA = nA; cB = nB; ++ui;
        if constexpr (ALIGN_EPI) { if (wr == 1) PG8_BAR; }
    }
    PG8_WAIT_V(0);
    if constexpr (!ALIGN_EPI) { if (wr == 0) PG8_BAR; }
    PG8_BAR;
    if constexpr (Epi::AFTER_DRAIN) { E.fused(acc, cur, wr, wc, fr, fq, lds, wid, lane); S.done(cur); }
#undef PG8_SA
#undef PG8_SB
#undef PG8_STAGE
#undef PG8_LDA
#undef PG8_LDB
#undef PG8_MMA
#undef PG8_WAIT_V
#undef PG8_WAIT_L
#undef PG8_BAR
#undef PG8_SCHED
}
}
#define GAS __attribute__((address_space(1)))
#define LAS __attribute__((address_space(3)))
typedef unsigned short bf16;
typedef unsigned v4u __attribute__((ext_vector_type(4)));
typedef float f32x4 __attribute__((ext_vector_type(4)));
typedef short bf16x8 __attribute__((ext_vector_type(8)));
typedef GAS unsigned gu32;
typedef GAS unsigned long long gu64;
#define RLX_AGENT __ATOMIC_RELAXED, __HIP_MEMORY_SCOPE_AGENT
#define LDS_WAIT() asm volatile("s_waitcnt lgkmcnt(0)" ::: "memory")
#define VM_WAIT() asm volatile("s_waitcnt vmcnt(0)" ::: "memory")
__device__ __forceinline__ unsigned long long rt() { return __builtin_amdgcn_s_memrealtime(); }
__device__ __forceinline__ unsigned f2bf(float f) { unsigned u = __builtin_bit_cast(unsigned, f); return (u + 0x7fffu + ((u >> 16) & 1u)) >> 16; }
__device__ __forceinline__ unsigned pk2(float lo, float hi) { return f2bf(lo) | (f2bf(hi) << 16); }

#define XB_TMO      128
#define XB_XCNT(j)  (256  + 64 * (j))
#define XB_XSUB(j)  (1280 + 64 * (j))
#define XB_XGEN(j)  (2304 + 64 * (j))
#define XB_TOP      3328
#define XB_TOPGEN   3392
#define XCD_BAR_WORDS 3456
#define XB_SPIN_CAP (1u << 18)

__device__ __forceinline__ unsigned xb_ld(unsigned* p)              { return __hip_atomic_load(p, __ATOMIC_RELAXED, __HIP_MEMORY_SCOPE_AGENT); }
__device__ __forceinline__ unsigned xb_add(unsigned* p, unsigned v) { return __hip_atomic_fetch_add(p, v, __ATOMIC_RELAXED, __HIP_MEMORY_SCOPE_AGENT); }
__device__ __forceinline__ unsigned xb_xcc_id() { return (unsigned)__builtin_amdgcn_s_getreg((3 << 11) | 20) & 0xFu; }
#define XB_SPIN(cond, bar) do { unsigned _sp = 0; while (cond) { __builtin_amdgcn_s_sleep(1); \
    if ((++_sp & 255u) == 0u) { if (xb_ld(&(bar)[XB_TMO])) break; if (_sp > XB_SPIN_CAP) { atomicAdd(&(bar)[XB_TMO], 1u); break; } } } } while (0)

struct XcdBarrier {
    unsigned* bar; unsigned x;
    volatile LAS unsigned* st;
};

__device__ __forceinline__ XcdBarrier xcd_barrier_post(unsigned* bar, volatile LAS unsigned* st) {
    XcdBarrier b; b.bar = bar; b.x = xb_xcc_id(); b.st = st;
    if (threadIdx.x == 0) (void)xb_add(&bar[XB_XCNT(b.x)], 1u);
    return b;
}
__device__ __forceinline__ void xcd_barrier_complete(unsigned* bar, unsigned x, unsigned& nloc, unsigned& nx) {
    const unsigned G = gridDim.x * gridDim.y * gridDim.z;
    unsigned sum, cnt, mine, sp = 0u;
    for (;;) {
        sum = 0u; cnt = 0u; mine = 0u;
#pragma unroll
        for (unsigned j = 0; j < 16; ++j) { const unsigned c = xb_ld(&bar[XB_XCNT(j)]); sum += c; cnt += (c > 0u) ? 1u : 0u; mine = (j == x) ? c : mine; }
        if (sum == G) break;
        __builtin_amdgcn_s_sleep(1);
        if ((++sp & 255u) == 0u) { if (xb_ld(&bar[XB_TMO])) break; if (sp > XB_SPIN_CAP) { atomicAdd(&bar[XB_TMO], 1u); break; } }
    }
    nloc = mine > 0u ? mine : 1u; nx = cnt > 0u ? cnt : 1u;
}

__device__ __forceinline__ void xcd_barrier(const XcdBarrier& b) {
    asm volatile("s_waitcnt vmcnt(0)" ::: "memory");
    __syncthreads();
    if (threadIdx.x == 0) {
        unsigned* bar = b.bar;
        __builtin_amdgcn_s_waitcnt(0);
        unsigned nloc = b.st[0], nx = b.st[1];
        if (nloc == 0u) { xcd_barrier_complete(bar, b.x, nloc, nx); b.st[0] = nloc; b.st[1] = nx; }
        const unsigned old = xb_add(&bar[XB_XSUB(b.x)], 1u);
        const unsigned gen = old / nloc;
        if (old + 1u == (gen + 1u) * nloc) {
            __builtin_amdgcn_fence(__ATOMIC_RELEASE, "agent");
            asm volatile("s_waitcnt vmcnt(0)" ::: "memory");
            const unsigned og = xb_add(&bar[XB_TOP], 1u);
            const unsigned tg = og / nx;
            if (og + 1u == (tg + 1u) * nx) xb_add(&bar[XB_TOPGEN], 1u);
            else XB_SPIN(xb_ld(&bar[XB_TOPGEN]) == tg, bar);
            __builtin_amdgcn_fence(__ATOMIC_ACQUIRE, "agent");
            xb_add(&bar[XB_XGEN(b.x)], 1u);
            asm volatile("s_waitcnt vmcnt(0)" ::: "memory");
        } else {
            XB_SPIN(xb_ld(&bar[XB_XGEN(b.x)]) == gen, bar);
            __builtin_amdgcn_fence(__ATOMIC_ACQUIRE, "agent");
            asm volatile("s_waitcnt vmcnt(0)" ::: "memory");
        }
    }
    __syncthreads();
}

constexpr int NWAVES = 8;
constexpr int BATCH = 4, SEQ = 8192, D = 1024, FF = 4096, CTXL = 256, NH = 8, HD = 64, ATT = 512, CONVD = 512, NIN = 2560, NMOD = 6 * D, CW = 31;
constexpr int M = BATCH * SEQ;
constexpr int MC = BATCH * CTXL;
constexpr float EPS = 1e-6f, LOG2E = 1.4426950408889634f;
#ifndef MK_N_LAUNCHES
#define MK_N_LAUNCHES 1
#endif
constexpr int N_PHASES = 8;

constexpr size_t MiB = 1u << 20;
constexpr size_t WS_CTL = 0, CTL_ZERO_BYTES = 64 * 1024;
constexpr size_t WS_MOD = 1 * MiB;
constexpr size_t WS_ROPE = WS_MOD + 128 * 1024;
constexpr size_t WS_S2 = WS_ROPE + 16 * 1024;
constexpr size_t WS_BIAS2 = WS_S2 + 16 * 1024;
constexpr size_t WS_WIN = 2 * MiB, WS_WOUT = 7 * MiB, WS_W1 = 9 * MiB, WS_W2 = 17 * MiB;
constexpr size_t WS_HC = 25 * MiB, WS_KC = 27 * MiB, WS_VC = 28 * MiB, WS_SSQ = 29 * MiB, WS_SSQ2 = 31 * MiB;
constexpr size_t WS_XS = 40 * MiB;
constexpr size_t WS_R = 104 * MiB;
constexpr size_t WS_HX = WS_R, WS_MIX = WS_R, WS_QROT = WS_R + 64 * MiB, WS_Q = WS_R + 96 * MiB, WS_KROT = WS_R + 128 * MiB, WS_V = WS_R + 160 * MiB, WS_HG = WS_R + 192 * MiB;
constexpr size_t WS_HID = WS_R, WS_END = WS_R + 256 * MiB;
constexpr int CW_BAR = 1024;

constexpr int RING_OFF = 0, RING_BYTES = 131072;
constexpr int LDSCTL_OFF = RING_BYTES, MISC_OFF = LDSCTL_OFF + 320;
constexpr int LDS_BYTES = 147456;

struct Args { const float* in[18]; float* out; unsigned char* ws; int ph_lo, ph_hi; };

struct Frame {
    LAS unsigned char* lds; volatile LAS unsigned* MISC; gu32* ctl;
    int tid, lane, wave, vcu, G;
};
__device__ __forceinline__ float wave_sum(float v) {
#pragma unroll
    for (int o = 1; o < 64; o <<= 1) v += __shfl_xor(v, o);
    return v;
}
__device__ __forceinline__ float wave_max(float v) {
#pragma unroll
    for (int o = 1; o < 64; o <<= 1) v = fmaxf(v, __shfl_xor(v, o));
    return v;
}
__device__ __forceinline__ float bf_lo(unsigned u) { return __builtin_bit_cast(float, u << 16); }
__device__ __forceinline__ float bf_hi(unsigned u) { return __builtin_bit_cast(float, u & 0xffff0000u); }
__device__ __forceinline__ float bf1(bf16 u) { return __builtin_bit_cast(float, (unsigned)u << 16); }

__host__ __device__ __forceinline__ int win_src(int p) {
    if (p < 1024) { const int g = p & ~31, i = p & 31; return g + 16 * ((i >> 2) & 1) + 4 * (i >> 3) + (i & 3); }
    if (p < 1536) return p;
    const int u = p - 1536, t = u >> 8, w = u & 255;
    return w < 128 ? 1536 + 128 * t + w : 2048 + 128 * t + (w - 128);
}
template <bool PERMW>
__device__ __forceinline__ void p0_transpose_item(const float* W, int K, int N, bf16* WT, LAS float* scr, int item, int lane) {
    const int nblk = N / 32, kb = item / nblk, nb = item % nblk, k0 = 64 * kb, n0 = 32 * nb;
    const int sc = PERMW ? win_src(n0 + (lane & 31)) : n0 + (lane & 31);
#pragma unroll 8
    for (int i = 0; i < 32; ++i) { const int kk = 2 * i + (lane >> 5); scr[kk * 33 + (lane & 31)] = W[(size_t)(k0 + kk) * N + sc]; }
    LDS_WAIT(); asm volatile("" ::: "memory");
    const int c = lane & 7;
#pragma unroll
    for (int j = 0; j < 4; ++j) { const int n = (lane >> 3) + 8 * j; const LAS float* s = scr + (8 * c) * 33 + n;
        v4u o; o.x = pk2(s[0 * 33], s[1 * 33]); o.y = pk2(s[2 * 33], s[3 * 33]); o.z = pk2(s[4 * 33], s[5 * 33]); o.w = pk2(s[6 * 33], s[7 * 33]);
        *(GAS v4u*)(WT + (size_t)(n0 + n) * K + k0 + 8 * c) = o; }
    LDS_WAIT(); asm volatile("" ::: "memory");
}
__device__ __forceinline__ float silu_f(float v) { return v / (1.0f + __expf(-v)); }

__device__ __forceinline__ void sincos_small(float a, float& sn, float& cs) {
    const double x = (double)a; const double k = __builtin_rint(x * 0.63661977236758134308); const double r = x - k * 1.57079632679489661923;
    const double r2 = r * r;
    const double s = r * (1.0 + r2 * (-1.0 / 6 + r2 * (1.0 / 120 + r2 * (-1.0 / 5040 + r2 * (1.0 / 362880 + r2 * (-1.0 / 39916800 + r2 * (1.0 / 6227020800.0)))))));
    const double c = 1.0 + r2 * (-0.5 + r2 * (1.0 / 24 + r2 * (-1.0 / 720 + r2 * (1.0 / 40320 + r2 * (-1.0 / 3628800 + r2 * (1.0 / 479001600.0 + r2 * (-1.0 / 87178291200.0)))))));
    const int q = ((int)k) & 3;
    const double ss = (q == 0) ? s : (q == 1) ? c : (q == 2) ? -s : -c;
    const double cc = (q == 0) ? c : (q == 1) ? -s : (q == 2) ? -c : s;
    sn = (float)ss; cs = (float)cc;
}

__device__ __forceinline__ void p0_prologue(Frame& F, const Args& A) {
    unsigned char* ws = A.ws;
    float* MOD = (float*)(ws + WS_MOD);
    if (F.vcu < 96) {
        LAS float* SL = (LAS float*)(F.lds);
        LAS float* RED = (LAS float*)(F.lds + 32768);
        const float* c = A.in[1]; const float* cc = A.in[3];
        for (int u = F.tid; u < 5 * 1024; u += NWAVES * 64) { const int i = u >> 10, k = u & 1023; const float v = (i < 4) ? c[i * 1024 + k] : cc[k]; SL[u] = silu_f(v); }
        __syncthreads();
        const float* Wa = A.in[4]; const int n = F.vcu * 64 + F.lane;
        float a0 = 0.f, a1 = 0.f, a2 = 0.f, a3 = 0.f, a4 = 0.f;
        const int kb = F.wave * 128;
#pragma unroll 8
        for (int k = kb; k < kb + 128; ++k) { const float w = Wa[(size_t)k * NMOD + n];
            a0 += SL[k] * w; a1 += SL[1024 + k] * w; a2 += SL[2048 + k] * w; a3 += SL[3072 + k] * w; a4 += SL[4096 + k] * w; }
        LAS float* r = RED + F.wave * 320 + F.lane;
        r[0] = a0; r[64] = a1; r[128] = a2; r[192] = a3; r[256] = a4;
        __syncthreads();
        if (F.tid < 320) { const int i = F.tid >> 6, l = F.tid & 63; float s = 0.f;
#pragma unroll
            for (int w = 0; w < 8; ++w) s += RED[w * 320 + i * 64 + l];
            MOD[i * NMOD + F.vcu * 64 + l] = s + A.in[5][F.vcu * 64 + l]; }
        __syncthreads();
    } else if (F.vcu < 100) {
        const float invf[16] = {1.0f, 0.5623413324356079f, 0.3162277638912201f, 0.17782793939113617f, 0.10000000149011612f, 0.05623413249850273f, 0.03162277489900589f, 0.017782794311642647f,
                                0.009999999776482582f, 0.005623413249850273f, 0.003162277629598975f, 0.0017782794311642647f, 0.0010000000474974513f, 0.000562341301701963f, 0.0003162277571391314f, 0.00017782794020604342f};
        float* ROPE = (float*)(ws + WS_ROPE);
        const int idx = (F.vcu - 96) * 512 + F.tid, pos = idx >> 4, i = idx & 15;
        float fi = invf[0];
#pragma unroll
        for (int j = 1; j < 16; ++j) fi = (i == j) ? invf[j] : fi;
        const float ang = (float)pos * fi; float sn, cs; sincos_small(ang, sn, cs);
        ROPE[idx * 2] = cs; ROPE[idx * 2 + 1] = sn;
    }
    LAS float* scr = (LAS float*)(F.lds + 40960 + F.wave * 8704);
    const int gw = F.vcu * NWAVES + F.wave, NGW = F.G * NWAVES;
    constexpr int I_IN = (D / 64) * (NIN / 32), I_O = (D / 64) * (D / 32), I_1 = (D / 64) * (FF / 32), I_2 = (FF / 64) * (D / 32);
    constexpr int NITEMS = I_IN + I_O + I_1 + I_2;
    bf16* WIN = (bf16*)(ws + WS_WIN); bf16* WOUT = (bf16*)(ws + WS_WOUT); bf16* W1 = (bf16*)(ws + WS_W1); bf16* W2 = (bf16*)(ws + WS_W2);
    for (int it = gw; it < NITEMS; it += NGW) {
        int r = it;
        if (r < I_IN) { p0_transpose_item<true>(A.in[8], D, NIN, WIN, scr, r, F.lane); continue; } r -= I_IN;
        if (r < I_O) { p0_transpose_item<false>(A.in[14], D, D, WOUT, scr, r, F.lane); continue; } r -= I_O;
        if (r < I_1) { p0_transpose_item<false>(A.in[15], D, FF, W1, scr, r, F.lane); continue; } r -= I_1;
        p0_transpose_item<false>(A.in[16], FF, D, W2, scr, r, F.lane);
    }
}

__device__ __forceinline__ void norm_mod_row(Frame& F, const float* xrow, bf16* orow, const float* g, const float* sh, const float* sc) {
    const GAS f32x4* xr = (const GAS f32x4*)xrow + F.lane;
    f32x4 v[4]; float s = 0.f;
#pragma unroll
    for (int j = 0; j < 4; ++j) { v[j] = xr[64 * j]; s += (v[j].x * v[j].x + v[j].y * v[j].y) + (v[j].z * v[j].z + v[j].w * v[j].w); }
    const float rstd = 1.0f / sqrtf(wave_sum(s) * (1.f / D) + EPS);
    GAS unsigned long long* o8 = (GAS unsigned long long*)orow + F.lane;
#pragma unroll
    for (int j = 0; j < 4; ++j) { const f32x4 gv = ((const f32x4*)g)[64 * j + F.lane], shv = ((const f32x4*)sh)[64 * j + F.lane], scv = ((const f32x4*)sc)[64 * j + F.lane];
        const f32x4 y = (v[j] * rstd * gv) * (scv + 1.0f) + shv;
        o8[64 * j] = (unsigned long long)pk2(y.x, y.y) | ((unsigned long long)pk2(y.z, y.w) << 32); }
}
__device__ __forceinline__ void p1_norm(Frame& F, const Args& A) {
    unsigned char* ws = A.ws; const float* MOD = (const float*)(ws + WS_MOD);
    const int gw = F.vcu * NWAVES + F.wave, NGW = F.G * NWAVES;
    bf16* HX = (bf16*)(ws + WS_HX); bf16* HC = (bf16*)(ws + WS_HC);
    for (int m = gw; m < M + MC; m += NGW) {
        if (m < M) { const int b = m >> 13; norm_mod_row(F, A.in[0] + (size_t)m * D, HX + (size_t)m * D, A.in[6], MOD + b * NMOD, MOD + b * NMOD + D); }
        else { const int mc = m - M; norm_mod_row(F, A.in[2] + (size_t)mc * D, HC + (size_t)mc * D, A.in[6], MOD + 4 * NMOD, MOD + 4 * NMOD + D); }
    }
    if (F.vcu == 0) { float* S2 = (float*)(ws + WS_S2);
        for (int u = F.tid; u < 4 * D; u += NWAVES * 64) { const int b = u >> 10, k = u & 1023; S2[u] = A.in[7][k] * (1.0f + MOD[b * NMOD + 4 * D + k]); } }
    const bf16* W1 = (const bf16*)(ws + WS_W1); float* B2 = (float*)(ws + WS_BIAS2);
    for (int n = gw; n < FF; n += NGW) {
        const v4u* wp = (const v4u*)(W1 + (size_t)n * D + 16 * F.lane); const v4u w0 = wp[0], w1 = wp[1];
        float wf[16] = {bf_lo(w0.x), bf_hi(w0.x), bf_lo(w0.y), bf_hi(w0.y), bf_lo(w0.z), bf_hi(w0.z), bf_lo(w0.w), bf_hi(w0.w),
                        bf_lo(w1.x), bf_hi(w1.x), bf_lo(w1.y), bf_hi(w1.y), bf_lo(w1.z), bf_hi(w1.z), bf_lo(w1.w), bf_hi(w1.w)};
#pragma unroll
        for (int b = 0; b < 4; ++b) { const f32x4* sp = (const f32x4*)(MOD + b * NMOD + 3 * D + 16 * F.lane); float s = 0.f;
#pragma unroll
            for (int q = 0; q < 4; ++q) { const f32x4 sv = sp[q]; s += (sv.x * wf[4 * q] + sv.y * wf[4 * q + 1]) + (sv.z * wf[4 * q + 2] + sv.w * wf[4 * q + 3]); }
            s = wave_sum(s); if (F.lane == 0) B2[b * FF + n] = s; }
    }
}

__device__ __forceinline__ float dot8(v4u a, v4u b) {
    return (bf_lo(a.x) * bf_lo(b.x) + bf_hi(a.x) * bf_hi(b.x)) + (bf_lo(a.y) * bf_lo(b.y) + bf_hi(a.y) * bf_hi(b.y)) + (bf_lo(a.z) * bf_lo(b.z) + bf_hi(a.z) * bf_hi(b.z)) + (bf_lo(a.w) * bf_lo(b.w) + bf_hi(a.w) * bf_hi(b.w));
}
__device__ __forceinline__ void p3_attn_naive(Frame& F, const Args& A) {
    unsigned char* ws = A.ws;
    const bf16* QROT = (const bf16*)(ws + WS_QROT); const bf16* Q = (const bf16*)(ws + WS_Q); const bf16* KROT = (const bf16*)(ws + WS_KROT); const bf16* V = (const bf16*)(ws + WS_V);
    const bf16* KC = (const bf16*)(ws + WS_KC); const bf16* VC = (const bf16*)(ws + WS_VC); bf16* MIX = (bf16*)(ws + WS_MIX);
    const float* rpb = A.in[13];
    LAS float* pbuf = (LAS float*)(F.lds) + F.wave * 384;
    const int gw = F.vcu * NWAVES + F.wave, NGW = F.G * NWAVES, lane = F.lane;
    for (int item = gw; item < M * NH; item += NGW) {
        const int row = item >> 3, h = item & 7, b = row >> 13, t = row & 8191, r = t >> 6, c = t & 63;
        const int rs = min(max(r - 4, 0), 120), cs = min(max(c - 8, 0), 48);
        const v4u* qrp = (const v4u*)(QROT + (size_t)row * ATT + h * HD); const v4u* qp = (const v4u*)(Q + (size_t)row * ATT + h * HD);
        float s[6];
#pragma unroll
        for (int j = 0; j < 2; ++j) { const int w = lane + 64 * j, i = w >> 4, jc = w & 15; const size_t kt = (size_t)b * SEQ + (rs + i) * 64 + cs + jc;
            const v4u* kp = (const v4u*)(KROT + kt * ATT + h * HD); float d = 0.f;
#pragma unroll
            for (int e = 0; e < 8; ++e) d += dot8(qrp[e], kp[e]);
            s[j] = d + rpb[h * 465 + (rs + i - r + 7) * 31 + (cs + jc - c + 15)] * LOG2E; }
#pragma unroll
        for (int j = 0; j < 4; ++j) { const int ci = lane + 64 * j; const v4u* kp = (const v4u*)(KC + (size_t)(b * CTXL + ci) * ATT + h * HD); float d = 0.f;
#pragma unroll
            for (int e = 0; e < 8; ++e) d += dot8(qp[e], kp[e]);
            s[2 + j] = d; }
        float mx = fmaxf(fmaxf(fmaxf(s[0], s[1]), fmaxf(s[2], s[3])), fmaxf(s[4], s[5])); mx = wave_max(mx);
        float l = 0.f;
#pragma unroll
        for (int j = 0; j < 6; ++j) { s[j] = __builtin_amdgcn_exp2f(s[j] - mx); l += s[j]; pbuf[lane + 64 * j] = s[j]; }
        l = wave_sum(l);
        LDS_WAIT(); asm volatile("" ::: "memory");
        float o = 0.f;
#pragma unroll 8
        for (int w = 0; w < 128; ++w) { const int i = w >> 4, jc = w & 15; const size_t kt = (size_t)b * SEQ + (rs + i) * 64 + cs + jc; o += pbuf[w] * bf1(V[kt * ATT + h * HD + lane]); }
#pragma unroll 8
        for (int ci = 0; ci < CTXL; ++ci) o += pbuf[128 + ci] * bf1(VC[(size_t)(b * CTXL + ci) * ATT + h * HD + lane]);
        MIX[(size_t)row * D + h * HD + lane] = (bf16)f2bf(o / l);
        LDS_WAIT(); asm volatile("" ::: "memory");
    }
}
__device__ __forceinline__ void p3_conv_naive(Frame& F, const Args& A) {
    unsigned char* ws = A.ws; const bf16* HG = (const bf16*)(ws + WS_HG); bf16* MIX = (bf16*)(ws + WS_MIX);
    const float* dwk = A.in[9]; const float* dwb = A.in[10]; const float* lg = A.in[11]; const float* lb = A.in[12];
    const int gw = F.vcu * NWAVES + F.wave, NGW = F.G * NWAVES, c0 = F.lane * 8;
    for (int row = gw; row < M; row += NGW) {
        const int b = row >> 13, t = row & 8191;
        const f32x4 b0 = *(const f32x4*)(dwb + c0), b1 = *(const f32x4*)(dwb + c0 + 4);
        float a[8] = {b0.x, b0.y, b0.z, b0.w, b1.x, b1.y, b1.z, b1.w};
        for (int j = 0; j < CW; ++j) { const int tt = t + j - 15; if (tt < 0 || tt >= SEQ) continue;
            const v4u hv = *(const v4u*)(HG + (size_t)(b * SEQ + tt) * CONVD + c0); const f32x4 k0 = *(const f32x4*)(dwk + j * CONVD + c0), k1 = *(const f32x4*)(dwk + j * CONVD + c0 + 4);
            a[0] += bf_lo(hv.x) * k0.x; a[1] += bf_hi(hv.x) * k0.y; a[2] += bf_lo(hv.y) * k0.z; a[3] += bf_hi(hv.y) * k0.w;
            a[4] += bf_lo(hv.z) * k1.x; a[5] += bf_hi(hv.z) * k1.y; a[6] += bf_lo(hv.w) * k1.z; a[7] += bf_hi(hv.w) * k1.w; }
        float s = 0.f;
#pragma unroll
        for (int e = 0; e < 8; ++e) s += a[e];
        const float mean = wave_sum(s) * (1.f / CONVD); float q = 0.f;
#pragma unroll
        for (int e = 0; e < 8; ++e) { a[e] -= mean; q += a[e] * a[e]; }
        const float rstd = 1.0f / sqrtf(wave_sum(q) * (1.f / CONVD) + EPS);
        const f32x4 g0 = *(const f32x4*)(lg + c0), g1 = *(const f32x4*)(lg + c0 + 4), e0 = *(const f32x4*)(lb + c0), e1 = *(const f32x4*)(lb + c0 + 4);
        const float gg[8] = {g0.x, g0.y, g0.z, g0.w, g1.x, g1.y, g1.z, g1.w}, bb[8] = {e0.x, e0.y, e0.z, e0.w, e1.x, e1.y, e1.z, e1.w};
        float y[8];
#pragma unroll
        for (int e = 0; e < 8; ++e) { const float v = a[e] * rstd * gg[e] + bb[e]; y[e] = silu_f(v); }
        v4u o; o.x = pk2(y[0], y[1]); o.y = pk2(y[2], y[3]); o.z = pk2(y[4], y[5]); o.w = pk2(y[6], y[7]);
        *(GAS v4u*)(MIX + (size_t)row * D + ATT + c0) = o;
    }
}

__device__ __forceinline__ void p7_final(Frame& F, const Args& A) {
    const float* SSQ2 = (const float*)(A.ws + WS_SSQ2); const float* fg = A.in[17];
    const int gw = F.vcu * NWAVES + F.wave, NGW = F.G * NWAVES;
    for (int m = gw; m < M; m += NGW) {
        const float pv = (F.lane < 16) ? SSQ2[(size_t)m * 16 + F.lane] : 0.f;
        const float rstd = 1.0f / sqrtf(wave_sum(pv) * (1.f / D) + EPS);
        GAS f32x4* xr = (GAS f32x4*)(A.out + (size_t)m * D) + F.lane;
#pragma unroll
        for (int j = 0; j < 4; ++j) { const f32x4 gv = ((const f32x4*)fg)[64 * j + F.lane]; xr[64 * j] = xr[64 * j] * rstd * gv; }
    }
}

__global__ void __launch_bounds__(NWAVES * 64, 2) hymba_fwd(Args args) {
    extern __shared__ __attribute__((aligned(16))) unsigned char lds[];
    Frame F;
    F.lds = (LAS unsigned char*)lds;
    F.MISC = (volatile LAS unsigned*)(F.lds + MISC_OFF);
    F.tid = threadIdx.x; F.lane = F.tid & 63; F.wave = __builtin_amdgcn_readfirstlane(F.tid >> 6);
    F.G = gridDim.x; { const int bx = blockIdx.x; F.vcu = (F.G % 8 == 0) ? (bx % 8) * (F.G / 8) + bx / 8 : bx; }
    unsigned char* ws = args.ws;
    F.ctl = (gu32*)(ws + WS_CTL);
    for (int u = F.tid; u < (LDS_BYTES - LDSCTL_OFF) / 4; u += NWAVES * 64) ((LAS unsigned*)(F.lds + LDSCTL_OFF))[u] = 0u;
    __syncthreads();
    const int lo = args.ph_lo, hi = args.ph_hi;
    XcdBarrier bar; bar.bar = (unsigned*)(F.ctl + CW_BAR); bar.x = 0; bar.st = nullptr;
    if (hi - lo > 1) bar = xcd_barrier_post((unsigned*)(F.ctl + CW_BAR), F.MISC + 8);
#define IN(k) (lo <= (k) && (k) < hi)
#define SEAM(k) do { if (IN(k) && IN((k) + 1)) xcd_barrier(bar); } while (0)

    if (IN(0)) { p0_prologue(F, args); SEAM(0); }
    if (IN(1)) { p1_norm(F, args); SEAM(1); }
    if (IN(2)) {
        { pg8::Gemm g{(const pg8::bf16_t*)(ws + WS_HX), (const pg8::bf16_t*)(ws + WS_WIN), M, NIN, D}; pg8::StaticOrder S; S.init(M, NIN, F.G, (int)blockIdx.x);
          pg8::EpiInProj E{(pg8::bf16_t*)(ws + WS_Q), (pg8::bf16_t*)(ws + WS_QROT), (pg8::bf16_t*)(ws + WS_KROT), (pg8::bf16_t*)(ws + WS_V), (pg8::bf16_t*)(ws + WS_HG), (const float*)(ws + WS_ROPE)};
          pg8::gemm_phase<pg8::EpiInProj, pg8::StaticOrder, true, true>(F.lds + RING_OFF, g, S, E); }
        { pg8::Gemm g{(const pg8::bf16_t*)(ws + WS_HC), (const pg8::bf16_t*)(ws + WS_WIN) + (size_t)512 * D, MC, 1024, D}; pg8::StaticOrder S; S.init(MC, 1024, F.G, (int)blockIdx.x);
          pg8::EpiCtx E{(pg8::bf16_t*)(ws + WS_KC), (pg8::bf16_t*)(ws + WS_VC)};
          pg8::gemm_phase<pg8::EpiCtx, pg8::StaticOrder, true, true>(F.lds + RING_OFF, g, S, E); }
        SEAM(2);
    }
    if (IN(3)) { p3_attn_naive(F, args); p3_conv_naive(F, args); SEAM(3); }
    if (IN(4)) {
        pg8::Gemm g{(const pg8::bf16_t*)(ws + WS_MIX), (const pg8::bf16_t*)(ws + WS_WOUT), M, D, D}; pg8::StaticOrder S; S.init(M, D, F.G, (int)blockIdx.x);
        pg8::EpiOutProj E{args.in[0], args.out, (pg8::bf16_t*)(ws + WS_XS), (float*)(ws + WS_SSQ), (const float*)(ws + WS_MOD), (const float*)(ws + WS_S2)};
        pg8::gemm_phase<pg8::EpiOutProj, pg8::StaticOrder, true, true>(F.lds + RING_OFF, g, S, E);
        SEAM(4);
    }
    if (IN(5)) {
        pg8::Gemm g{(const pg8::bf16_t*)(ws + WS_XS), (const pg8::bf16_t*)(ws + WS_W1), M, FF, D}; pg8::StaticOrder S; S.init(M, FF, F.G, (int)blockIdx.x);
        pg8::EpiMlp1 E{(pg8::bf16_t*)(ws + WS_HID), (const float*)(ws + WS_SSQ), (const float*)(ws + WS_BIAS2), EPS};
        pg8::gemm_phase<pg8::EpiMlp1, pg8::StaticOrder, true, true>(F.lds + RING_OFF, g, S, E);
        SEAM(5);
    }
    if (IN(6)) {
        pg8::Gemm g{(const pg8::bf16_t*)(ws + WS_HID), (const pg8::bf16_t*)(ws + WS_W2), M, D, FF}; pg8::StaticOrder S; S.init(M, D, F.G, (int)blockIdx.x);
        pg8::EpiMlp2 E{args.out, (float*)(ws + WS_SSQ2), (const float*)(ws + WS_MOD)};
        pg8::gemm_phase<pg8::EpiMlp2, pg8::StaticOrder, true, true>(F.lds + RING_OFF, g, S, E);
        SEAM(6);
    }
    if (IN(7)) { p7_final(F, args); }
#undef IN
#undef SEAM
}

extern "C" void kernel_launch(void* const* d_in, const int* in_sizes, int n_in, void* d_out, int out_size, void* d_ws, size_t ws_size, hipStream_t stream) {
    static int grid = 0;
    if (grid == 0) {
        if (n_in != 18 || in_sizes[0] != M * D || out_size != M * D || ws_size < WS_END) { fprintf(stderr, "kernel_launch: unexpected shapes (n_in %d, in0 %d, out %d, ws %zu)\n", n_in, n_in > 0 ? in_sizes[0] : -1, out_size, ws_size); grid = -1; return; }
        int dev = 0, cus = 0, per_cu = 0;
        if (hipGetDevice(&dev) != hipSuccess || hipDeviceGetAttribute(&cus, hipDeviceAttributeMultiprocessorCount, dev) != hipSuccess) { grid = -1; return; }
        if (hipFuncSetAttribute((const void*)hymba_fwd, hipFuncAttributeMaxDynamicSharedMemorySize, LDS_BYTES) != hipSuccess) { fprintf(stderr, "kernel_launch: hipFuncSetAttribute failed\n"); grid = -1; return; }
        if (hipOccupancyMaxActiveBlocksPerMultiprocessor(&per_cu, (const void*)hymba_fwd, NWAVES * 64, LDS_BYTES) != hipSuccess || per_cu < 1) { fprintf(stderr, "kernel_launch: occupancy query says %d\n", per_cu); per_cu = 1; }
        (void)hipGetLastError();
        grid = cus;
    }
    if (grid < 0) return;
    if (hipMemsetAsync((char*)d_ws + WS_CTL, 0, CTL_ZERO_BYTES, stream) != hipSuccess) return;
    Args a{};
    for (int i = 0; i < 18; ++i) a.in[i] = (const float*)d_in[i];
    a.out = (float*)d_out; a.ws = (unsigned char*)d_ws;
#if MK_N_LAUNCHES == 1
    a.ph_lo = 0; a.ph_hi = N_PHASES;
    hipLaunchKernelGGL(hymba_fwd, dim3(grid), dim3(NWAVES * 64), LDS_BYTES, stream, a);
#else
    for (int p = 0; p < N_PHASES; ++p) { a.ph_lo = p; a.ph_hi = p + 1; hipLaunchKernelGGL(hymba_fwd, dim3(grid), dim3(NWAVES * 64), LDS_BYTES, stream, a); }
#endif
}
```

```cpp
#include <hip/hip_runtime.h>
#include <cstdio>
#include <cstdint>
namespace pg8 {
#define PG8_LAS __attribute__((address_space(3)))
typedef unsigned short bf16_t;
typedef short bf16x8 __attribute__((ext_vector_type(8)));
typedef float f32x4 __attribute__((ext_vector_type(4)));
typedef unsigned u32x4 __attribute__((ext_vector_type(4)));
constexpr int BM = 256, BK = 64, HALF = 128, HTB = HALF * BK * 2  , STAGE_BYTES = 8 * HTB, NXCD = 8, WGM = 8;

__host__ __device__ __forceinline__ int lds_byte(int r, int c) { const int st = (r >> 4) * 2 + (c >> 5), rr = r & 15, cc = c & 31, ob = rr * 64 + cc * 2; return st * 1024 + (ob ^ (((ob >> 9) & 1) << 5)); }
__host__ __device__ __forceinline__ void stage_rc(int b, int& R, int& C) { const int st = b / 1024, sb = b % 1024, swz = sb ^ (((sb >> 9) & 1) << 5); R = (st >> 1) * 16 + swz / 64; C = (st & 1) * 32 + (swz % 64) / 2; }
__host__ __device__ __forceinline__ int perm32(int rho) { const int n = rho >> 4, i = rho & 15; return 8 * (i >> 2) + 4 * n + (i & 3); }

struct Unit { int pm, pn; };
struct Gemm { const bf16_t* A; const bf16_t* Bt; int M, N, K; };

struct StaticOrder {
    int nM, nN, nwg, G, c;
    __host__ __device__ void init(int M, int N, int G_, int c_) { nM = M / BM; nN = N / BM; nwg = nM * nN; G = G_; c = c_; }
    __host__ __device__ bool next(int i, Unit& u) const {
        const long L = (long)i * G + c; if (L >= nwg) return false;
        int wgid = (int)L; { const int q = nwg / NXCD, r = nwg % NXCD, xcd = wgid % NXCD, off = wgid / NXCD; wgid = (xcd < r ? xcd * (q + 1) : r * (q + 1) + (xcd - r) * q) + off; }
        const int nig = WGM * nN, gid = wgid / nig, fm = gid * WGM, gsz = (nM - fm) < WGM ? (nM - fm) : WGM;
        u.pm = fm + ((wgid % nig) % gsz); u.pn = (wgid % nig) / gsz; return true;
    }
    __device__ __forceinline__ void a_ready(const Unit&) const {}
    __device__ __forceinline__ void done(const Unit&) const {}
};


typedef float f32x2 __attribute__((ext_vector_type(2)));
typedef __bf16 bf16x2_t __attribute__((ext_vector_type(2)));
typedef unsigned u32x2 __attribute__((ext_vector_type(2)));
__device__ __forceinline__ unsigned cvt_pk_bf16(float lo, float hi) { f32x2 v = {lo, hi}; bf16x2_t b = __builtin_convertvector(v, bf16x2_t); return __builtin_bit_cast(unsigned, b); }
__device__ __forceinline__ u32x4 pack8(f32x4 a, f32x4 b) { u32x4 w; w.x = cvt_pk_bf16(a[0], a[1]); w.y = cvt_pk_bf16(a[2], a[3]); w.z = cvt_pk_bf16(b[0], b[1]); w.w = cvt_pk_bf16(b[2], b[3]); return w; }
constexpr float QSCALE = 0.125f * 1.4426950408889634f;
constexpr int SEQ_L = 8192, GRID_WL = 64;

struct EpiInProj {
    static constexpr bool PERM = true, AFTER_DRAIN = false;
    bf16_t *Q, *QROT, *KROT, *V, *HG; const float* rope;
    __device__ __forceinline__ void operator()(const f32x4 (&acc)[2][2][4][2], const Unit& u, int wr, int wc, int fr, int fq) const {
        const int row0 = u.pm * BM + wr * 64 + fr; const int pn = u.pn;
        if (pn < 4) {
            const int cb = (pn & 1) * 256 + wc * 32 + 8 * fq; const int axis = wc & 1;
#pragma unroll
            for (int ai = 0; ai < 2; ++ai)
#pragma unroll
                for (int m = 0; m < 4; ++m) {
                    const int row = row0 + ai * HALF + m * 16, tok = row & (SEQ_L - 1), pos = axis ? (tok & (GRID_WL - 1)) : (tok >> 6);
                    const f32x4* rp = (const f32x4*)(rope + (pos * 16 + 4 * fq) * 2); const f32x4 cs0 = rp[0], cs1 = rp[1];
                    const f32x4 c = {cs0[0], cs0[2], cs1[0], cs1[2]}, s = {cs0[1], cs0[3], cs1[1], cs1[3]};
#pragma unroll
                    for (int bj = 0; bj < 2; ++bj) {
                        const f32x4 x1 = acc[ai][bj][m][0], x2 = acc[ai][bj][m][1];
                        const f32x4 r1 = x1 * c - x2 * s, r2 = x2 * c + x1 * s;
                        const size_t off = (size_t)row * 512 + cb + bj * HALF;
                        if (pn < 2) { *(u32x4*)(Q + off) = pack8(x1 * QSCALE, x2 * QSCALE); *(u32x4*)(QROT + off) = pack8(r1 * QSCALE, r2 * QSCALE); }
                        else *(u32x4*)(KROT + off) = pack8(r1, r2);
                    }
                }
        } else if (pn < 6) {
            const int cb = (pn & 1) * 256 + wc * 32 + 8 * fq;
#pragma unroll
            for (int ai = 0; ai < 2; ++ai)
#pragma unroll
                for (int m = 0; m < 4; ++m) { const int row = row0 + ai * HALF + m * 16;
#pragma unroll
                    for (int bj = 0; bj < 2; ++bj) *(u32x4*)(V + (size_t)row * 512 + cb + bj * HALF) = pack8(acc[ai][bj][m][0], acc[ai][bj][m][1]); }
        } else {
            const int cb = (pn - 6) * 128 + wc * 32 + 8 * fq;
#pragma unroll
            for (int ai = 0; ai < 2; ++ai)
#pragma unroll
                for (int m = 0; m < 4; ++m) { const int row = row0 + ai * HALF + m * 16; f32x4 h[2];
#pragma unroll
                    for (int n = 0; n < 2; ++n) { const f32x4 a = acc[ai][0][m][n], b = acc[ai][1][m][n];
#pragma unroll
                        for (int e = 0; e < 4; ++e) h[n][e] = a[e] * __builtin_amdgcn_rcpf(1.0f + __builtin_amdgcn_exp2f(-1.4426950408889634f * b[e])); }
                    *(u32x4*)(HG + (size_t)row * 512 + cb) = pack8(h[0], h[1]); }
        }
    }
};
struct EpiCtx {
    static constexpr bool PERM = true, AFTER_DRAIN = false;
    bf16_t *KC, *VC;
    __device__ __forceinline__ void operator()(const f32x4 (&acc)[2][2][4][2], const Unit& u, int wr, int wc, int fr, int fq) const {
        const int row0 = u.pm * BM + wr * 64 + fr; bf16_t* O = u.pn < 2 ? KC : VC; const int cb = (u.pn & 1) * 256 + wc * 32 + 8 * fq;
#pragma unroll
        for (int ai = 0; ai < 2; ++ai)
#pragma unroll
            for (int m = 0; m < 4; ++m) { const int row = row0 + ai * HALF + m * 16;
#pragma unroll
                for (int bj = 0; bj < 2; ++bj) *(u32x4*)(O + (size_t)row * 512 + cb + bj * HALF) = pack8(acc[ai][bj][m][0], acc[ai][bj][m][1]); }
    }
};
struct EpiOutProj {
    static constexpr bool PERM = false, AFTER_DRAIN = false;
    const float* X; float* XN; bf16_t* XS; float* SSQ; const float* mod; const float* S2;
    __device__ __forceinline__ void operator()(const f32x4 (&acc)[2][2][4][2], const Unit& u, int wr, int wc, int fr, int fq) const {
        const int row0 = u.pm * BM + wr * 64 + fr, col0 = u.pn * BM + wc * 32 + 4 * fq; const int b = (u.pm * BM) >> 13;
        f32x4 g1[2][2], s2[2][2];
#pragma unroll
        for (int bj = 0; bj < 2; ++bj)
#pragma unroll
            for (int n = 0; n < 2; ++n) { g1[bj][n] = *(const f32x4*)(mod + b * 6144 + 2048 + col0 + bj * HALF + n * 16); s2[bj][n] = *(const f32x4*)(S2 + b * 1024 + col0 + bj * HALF + n * 16); }
#pragma unroll
        for (int ai = 0; ai < 2; ++ai)
#pragma unroll
            for (int m = 0; m < 4; ++m) { const int row = row0 + ai * HALF + m * 16; const size_t off = (size_t)row * 1024 + col0; float q = 0.f;
#pragma unroll
                for (int bj = 0; bj < 2; ++bj)
#pragma unroll
                    for (int n = 0; n < 2; ++n) { const f32x4 xv = *(const f32x4*)(X + off + bj * HALF + n * 16); const f32x4 xn = xv + g1[bj][n] * acc[ai][bj][m][n];
                        *(f32x4*)(XN + off + bj * HALF + n * 16) = xn; q += (xn[0] * xn[0] + xn[1] * xn[1]) + (xn[2] * xn[2] + xn[3] * xn[3]);
                        const f32x4 xs = xn * s2[bj][n]; u32x2 w; w.x = cvt_pk_bf16(xs[0], xs[1]); w.y = cvt_pk_bf16(xs[2], xs[3]); *(u32x2*)(XS + off + bj * HALF + n * 16) = w; }
                q += __shfl_xor(q, 16); q += __shfl_xor(q, 32);
                if (fq == 0) SSQ[(size_t)row * 16 + u.pn * 4 + wc] = q; }
    }
};
struct EpiMlp1 {
    static constexpr bool PERM = true, AFTER_DRAIN = false;
    bf16_t* HID; const float* SSQ; const float* BIAS2; float eps;
    __device__ __forceinline__ void operator()(const f32x4 (&acc)[2][2][4][2], const Unit& u, int wr, int wc, int fr, int fq) const {
        const int row0 = u.pm * BM + wr * 64 + fr, col0 = u.pn * BM + wc * 32 + 8 * fq; const int b = (u.pm * BM) >> 13;
        f32x4 bv[2][2];
#pragma unroll
        for (int bj = 0; bj < 2; ++bj)
#pragma unroll
            for (int n = 0; n < 2; ++n) bv[bj][n] = *(const f32x4*)(BIAS2 + b * 4096 + col0 + bj * HALF + 4 * n);
#pragma unroll
        for (int ai = 0; ai < 2; ++ai)
#pragma unroll
            for (int m = 0; m < 4; ++m) { const int row = row0 + ai * HALF + m * 16; const f32x4* sp = (const f32x4*)(SSQ + (size_t)row * 16);
                const f32x4 s0 = sp[0], s1 = sp[1], s2 = sp[2], s3 = sp[3];
                const float ss = ((s0[0] + s0[1]) + (s0[2] + s0[3])) + ((s1[0] + s1[1]) + (s1[2] + s1[3])) + ((s2[0] + s2[1]) + (s2[2] + s2[3])) + ((s3[0] + s3[1]) + (s3[2] + s3[3]));
                const float rstd = 1.0f / sqrtf(ss * (1.0f / 1024.0f) + eps);
#pragma unroll
                for (int bj = 0; bj < 2; ++bj) { f32x4 v0 = acc[ai][bj][m][0] * rstd + bv[bj][0], v1 = acc[ai][bj][m][1] * rstd + bv[bj][1];
#pragma unroll
                    for (int e = 0; e < 4; ++e) { const float a0 = fmaxf(v0[e], 0.f), a1 = fmaxf(v1[e], 0.f); v0[e] = a0 * a0; v1[e] = a1 * a1; }
                    *(u32x4*)(HID + (size_t)row * 4096 + col0 + bj * HALF) = pack8(v0, v1); } }
    }
};
struct EpiMlp2 {
    static constexpr bool PERM = false, AFTER_DRAIN = false;
    float* Y; float* SSQ; const float* mod;
    __device__ __forceinline__ void operator()(const f32x4 (&acc)[2][2][4][2], const Unit& u, int wr, int wc, int fr, int fq) const {
        const int row0 = u.pm * BM + wr * 64 + fr, col0 = u.pn * BM + wc * 32 + 4 * fq; const int b = (u.pm * BM) >> 13;
        f32x4 g2[2][2];
#pragma unroll
        for (int bj = 0; bj < 2; ++bj)
#pragma unroll
            for (int n = 0; n < 2; ++n) g2[bj][n] = *(const f32x4*)(mod + b * 6144 + 5120 + col0 + bj * HALF + n * 16);
#pragma unroll
        for (int ai = 0; ai < 2; ++ai)
#pragma unroll
            for (int m = 0; m < 4; ++m) { const int row = row0 + ai * HALF + m * 16; const size_t off = (size_t)row * 1024 + col0; float q = 0.f;
#pragma unroll
                for (int bj = 0; bj < 2; ++bj)
#pragma unroll
                    for (int n = 0; n < 2; ++n) { const f32x4 xv = *(const f32x4*)(Y + off + bj * HALF + n * 16); const f32x4 y = xv + g2[bj][n] * acc[ai][bj][m][n];
                        *(f32x4*)(Y + off + bj * HALF + n * 16) = y; q += (y[0] * y[0] + y[1] * y[1]) + (y[2] * y[2] + y[3] * y[3]); }
                q += __shfl_xor(q, 16); q += __shfl_xor(q, 32);
                if (fq == 0) SSQ[(size_t)row * 16 + u.pn * 4 + wc] = q; }
    }
};

template <class Epi, class Sched, bool ALIGN_EPI = false, bool SP2 = false>
__device__ __forceinline__ void gemm_phase(PG8_LAS unsigned char* lds, const Gemm g, const Sched& S, const Epi& E) {
    const int tid = threadIdx.x, wid = __builtin_amdgcn_readfirstlane(tid >> 6), lane = tid & 63, wr = wid >> 2, wc = wid & 3, fr = lane & 15, fq = lane >> 4;
    const int K = g.K, nt = K / BK;
    unsigned voffA[2], voffB[2];
#pragma unroll
    for (int i = 0; i < 2; ++i) { int R, C; stage_rc(tid * 16 + i * 8192, R, C); const int Rb = Epi::PERM ? ((R & ~31) + perm32(R & 31)) : R;
        voffA[i] = (unsigned)(R * K + C) * 2u; voffB[i] = (unsigned)(Rb * K + C) * 2u; }
    const size_t kstep = (size_t)(BK * 2);
    const size_t hstep = (size_t)HALF * K * 2;
    const size_t tstep = 2 * hstep;
    const unsigned ldsw = (unsigned)wid * 1024u;
    const int aoff = lds_byte(wr * 64 + fr, fq * 8), boff = lds_byte(wc * 32 + fr, fq * 8);
#define PG8_SA(b, h) (((b) * 2 + (h)) * HTB)
#define PG8_SB(b, h) ((4 + (b) * 2 + (h)) * HTB)
#define PG8_STAGE(bufoff, gbase, voff) do { _Pragma("unroll") for (int _i = 0; _i < 2; ++_i) \
        __builtin_amdgcn_global_load_lds((const unsigned*)((const char*)(gbase) + (voff)[_i]), (PG8_LAS unsigned*)(lds + (bufoff) + ldsw + _i * 8192), 16, 0, 0); } while (0)
#define PG8_LDA(dst, b, h) do { _Pragma("unroll") for (int m = 0; m < 4; ++m) _Pragma("unroll") for (int k = 0; k < 2; ++k) dst[m][k] = *(const PG8_LAS bf16x8*)(lds + PG8_SA(b, h) + aoff + m * 2048 + k * 1024); } while (0)
#define PG8_LDB(dst, b, h) do { _Pragma("unroll") for (int n = 0; n < 2; ++n) _Pragma("unroll") for (int k = 0; k < 2; ++k) dst[n][k] = *(const PG8_LAS bf16x8*)(lds + PG8_SB(b, h) + boff + n * 2048 + k * 1024); } while (0)
#define PG8_MMA(ai, bj, At, Bt) do { __builtin_amdgcn_s_setprio(1); _Pragma("unroll") for (int m = 0; m < 4; ++m) _Pragma("unroll") for (int n = 0; n < 2; ++n) _Pragma("unroll") for (int k = 0; k < 2; ++k) \
        acc[ai][bj][m][n] = __builtin_amdgcn_mfma_f32_16x16x32_bf16(Bt[n][k], At[m][k], acc[ai][bj][m][n], 0, 0, 0); __builtin_amdgcn_s_setprio(0); } while (0)
#define PG8_WAIT_V(n) asm volatile("s_waitcnt vmcnt(" #n ")" ::: "memory")
#define PG8_WAIT_L(n) asm volatile("s_waitcnt lgkmcnt(" #n ")" ::: "memory")
#define PG8_BAR __builtin_amdgcn_s_barrier()
#define PG8_SCHED __builtin_amdgcn_sched_barrier(0)
    Unit cur, nxt; int ui = 0;
    if (!S.next(0, cur)) return;
    f32x4 acc[2][2][4][2];
#pragma unroll
    for (int a = 0; a < 2; ++a)
#pragma unroll
        for (int b = 0; b < 2; ++b)
#pragma unroll
            for (int m = 0; m < 4; ++m)
#pragma unroll
                for (int n = 0; n < 2; ++n) acc[a][b][m][n] = (f32x4){0.f, 0.f, 0.f, 0.f};
    bf16x8 At[4][2], B0[2][2], B1[2][2];
    const char* cA = (const char*)g.A + (size_t)cur.pm * tstep; const char* cB = (const char*)g.Bt + (size_t)cur.pn * tstep;
    S.a_ready(cur);
    if constexpr (SP2) {
        PG8_STAGE(PG8_SB(0, 0), cB, voffB); PG8_STAGE(PG8_SB(0, 1), cB + hstep, voffB); PG8_STAGE(PG8_SA(0, 0), cA, voffA); PG8_STAGE(PG8_SA(0, 1), cA + hstep, voffA);
        if (wr == 1) PG8_BAR;
        PG8_WAIT_V(2); PG8_BAR;
        PG8_STAGE(PG8_SB(1, 0), cB + kstep, voffB); PG8_STAGE(PG8_SA(1, 0), cA + kstep, voffA); PG8_STAGE(PG8_SB(1, 1), cB + hstep + kstep, voffB);
        PG8_WAIT_V(6); PG8_BAR;
    } else {
        PG8_STAGE(PG8_SB(0, 0), cB, voffB); PG8_STAGE(PG8_SA(0, 0), cA, voffA); PG8_STAGE(PG8_SB(0, 1), cB + hstep, voffB); PG8_STAGE(PG8_SA(0, 1), cA + hstep, voffA);
        if (wr == 1) PG8_BAR;
        PG8_WAIT_V(4); PG8_BAR;
        PG8_STAGE(PG8_SB(1, 0), cB + kstep, voffB); PG8_STAGE(PG8_SA(1, 0), cA + kstep, voffA); PG8_STAGE(PG8_SB(1, 1), cB + hstep + kstep, voffB);
        PG8_WAIT_V(6); PG8_BAR;
    }
    for (;;) {
        const bool has_next = S.next(ui + 1, nxt);
        const char* nA = has_next ? (const char*)g.A + (size_t)nxt.pm * tstep : cA; const char* nB = has_next ? (const char*)g.Bt + (size_t)nxt.pn * tstep : cB;
        for (int t = 0; t < nt; t += 2) {
            const bool last = (t == nt - 2);
            const char* a1 = cA + (size_t)(t + 1) * kstep;
            const char* a2 = last ? nA : cA + (size_t)(t + 2) * kstep; const char* b2 = last ? nB : cB + (size_t)(t + 2) * kstep;
            const char* a3 = a2 + kstep; const char* b3 = b2 + kstep;
            if (last && has_next) S.a_ready(nxt);
            if constexpr (SP2) {
            PG8_LDB(B0, 0, 0); PG8_LDB(B1, 0, 1); PG8_SCHED; PG8_LDA(At, 0, 0); PG8_STAGE(PG8_SA(1, 1), a1 + hstep, voffA);
            PG8_WAIT_V(8); PG8_WAIT_L(0); PG8_BAR; PG8_MMA(0, 0, At, B0); PG8_MMA(0, 1, At, B1); PG8_BAR; PG8_SCHED;
            PG8_LDA(At, 0, 1); PG8_STAGE(PG8_SB(0, 0), b2, voffB); PG8_STAGE(PG8_SB(0, 1), b2 + hstep, voffB); PG8_STAGE(PG8_SA(0, 0), a2, voffA);
            PG8_WAIT_V(8); PG8_WAIT_L(0); PG8_BAR; PG8_MMA(1, 0, At, B0); PG8_MMA(1, 1, At, B1); PG8_BAR; PG8_SCHED;
            PG8_LDB(B0, 1, 0); PG8_LDB(B1, 1, 1); PG8_SCHED; PG8_LDA(At, 1, 0); PG8_STAGE(PG8_SA(0, 1), a2 + hstep, voffA);
            PG8_WAIT_V(8); PG8_WAIT_L(0); PG8_BAR; PG8_MMA(0, 0, At, B0); PG8_MMA(0, 1, At, B1); PG8_BAR; PG8_SCHED;
            PG8_LDA(At, 1, 1); PG8_STAGE(PG8_SB(1, 0), b3, voffB); PG8_STAGE(PG8_SB(1, 1), b3 + hstep, voffB); PG8_STAGE(PG8_SA(1, 0), a3, voffA);
            PG8_WAIT_V(8); PG8_WAIT_L(0); PG8_BAR; PG8_MMA(1, 0, At, B0); PG8_MMA(1, 1, At, B1); PG8_BAR; PG8_SCHED;
            } else {
            PG8_LDB(B0, 0, 0); PG8_SCHED; PG8_LDA(At, 0, 0); PG8_STAGE(PG8_SA(1, 1), a1 + hstep, voffA);
            PG8_WAIT_L(8); PG8_BAR; PG8_WAIT_L(0); PG8_MMA(0, 0, At, B0); PG8_BAR; PG8_SCHED;
            PG8_LDB(B1, 0, 1); PG8_STAGE(PG8_SB(0, 0), b2, voffB);
            PG8_BAR; PG8_WAIT_L(0); PG8_MMA(0, 1, At, B1); PG8_BAR;
            PG8_LDA(At, 0, 1); PG8_STAGE(PG8_SA(0, 0), a2, voffA);
            PG8_BAR; PG8_WAIT_L(0); PG8_MMA(1, 0, At, B0); PG8_BAR; PG8_SCHED;
            PG8_STAGE(PG8_SB(0, 1), b2 + hstep, voffB);
            PG8_WAIT_V(6); PG8_BAR; PG8_MMA(1, 1, At, B1); PG8_BAR;
            PG8_LDB(B0, 1, 0); PG8_SCHED; PG8_LDA(At, 1, 0); PG8_STAGE(PG8_SA(0, 1), a2 + hstep, voffA);
            PG8_WAIT_L(8); PG8_BAR; PG8_WAIT_L(0); PG8_MMA(0, 0, At, B0); PG8_BAR; PG8_SCHED;
            PG8_LDB(B1, 1, 1); PG8_STAGE(PG8_SB(1, 0), b3, voffB);
            PG8_BAR; PG8_WAIT_L(0); PG8_MMA(0, 1, At, B1); PG8_BAR;
            PG8_LDA(At, 1, 1); PG8_STAGE(PG8_SA(1, 0), a3, voffA);
            PG8_BAR; PG8_WAIT_L(0); PG8_MMA(1, 0, At, B0); PG8_BAR; PG8_SCHED;
            PG8_STAGE(PG8_SB(1, 1), b3 + hstep, voffB);
            PG8_WAIT_V(6); PG8_BAR; PG8_MMA(1, 1, At, B1); PG8_BAR;
            }
        }
        if constexpr (ALIGN_EPI) { if (wr == 0) PG8_BAR; }
        if constexpr (!Epi::AFTER_DRAIN) { E(acc, cur, wr, wc, fr, fq); S.done(cur); }
        if (!has_next) break;
#pragma unroll
        for (int a = 0; a < 2; ++a)
#pragma unroll
            for (int b = 0; b < 2; ++b)
#pragma unroll
                for (int m = 0; m < 4; ++m)
#pragma unroll
                    for (int n = 0; n < 2; ++n) acc[a][b][m][n] = (f32x4){0.f, 0.f, 0.f, 0.f};
        cur = nxt; cA = nA; cB = nB; ++ui;
        if constexpr (ALIGN_EPI) { if (wr == 1) PG8_BAR; }
    }
    PG8_WAIT_V(0);
    if constexpr (!ALIGN_EPI) { if (wr == 0) PG8_BAR; }
    PG8_BAR;
    if constexpr (Epi::AFTER_DRAIN) { E.fused(acc, cur, wr, wc, fr, fq, lds, wid, lane); S.done(cur); }
#undef PG8_SA
#undef PG8_SB
#undef PG8_STAGE
#undef PG8_LDA
#undef PG8_LDB
#undef PG8_MMA
#undef PG8_WAIT_V
#undef PG8_WAIT_L
#undef PG8_BAR
#undef PG8_SCHED
}
}
#define GAS __attribute__((address_space(1)))
#define LAS __attribute__((address_space(3)))
typedef unsigned short bf16;
typedef unsigned v4u __attribute__((ext_vector_type(4)));
typedef float f32x4 __attribute__((ext_vector_type(4)));
typedef short bf16x8 __attribute__((ext_vector_type(8)));
typedef GAS unsigned gu32;
typedef GAS unsigned long long gu64;
#define RLX_AGENT __ATOMIC_RELAXED, __HIP_MEMORY_SCOPE_AGENT
#define LDS_WAIT() asm volatile("s_waitcnt lgkmcnt(0)" ::: "memory")
#define VM_WAIT() asm volatile("s_waitcnt vmcnt(0)" ::: "memory")
__device__ __forceinline__ unsigned long long rt() { return __builtin_amdgcn_s_memrealtime(); }
__device__ __forceinline__ unsigned f2bf(float f) { unsigned u = __builtin_bit_cast(unsigned, f); return (u + 0x7fffu + ((u >> 16) & 1u)) >> 16; }
__device__ __forceinline__ unsigned pk2(float lo, float hi) { return f2bf(lo) | (f2bf(hi) << 16); }

#define XB_TMO      128
#define XB_XCNT(j)  (256  + 64 * (j))
#define XB_XSUB(j)  (1280 + 64 * (j))
#define XB_XGEN(j)  (2304 + 64 * (j))
#define XB_TOP      3328
#define XB_TOPGEN   3392
#define XCD_BAR_WORDS 3456
#define XB_SPIN_CAP (1u << 18)

__device__ __forceinline__ unsigned xb_ld(unsigned* p)              { return __hip_atomic_load(p, __ATOMIC_RELAXED, __HIP_MEMORY_SCOPE_AGENT); }
__device__ __forceinline__ unsigned xb_add(unsigned* p, unsigned v) { return __hip_atomic_fetch_add(p, v, __ATOMIC_RELAXED, __HIP_MEMORY_SCOPE_AGENT); }
__device__ __forceinline__ unsigned xb_xcc_id() { return (unsigned)__builtin_amdgcn_s_getreg((3 << 11) | 20) & 0xFu; }
#define XB_SPIN(cond, bar) do { unsigned _sp = 0; while (cond) { __builtin_amdgcn_s_sleep(1); \
    if ((++_sp & 255u) == 0u) { if (xb_ld(&(bar)[XB_TMO])) break; if (_sp > XB_SPIN_CAP) { atomicAdd(&(bar)[XB_TMO], 1u); break; } } } } while (0)

struct XcdBarrier {
    unsigned* bar; unsigned x;
    volatile LAS unsigned* st;
};

__device__ __forceinline__ XcdBarrier xcd_barrier_post(unsigned* bar, volatile LAS unsigned* st) {
    XcdBarrier b; b.bar = bar; b.x = xb_xcc_id(); b.st = st;
    if (threadIdx.x == 0) (void)xb_add(&bar[XB_XCNT(b.x)], 1u);
    return b;
}
__device__ __forceinline__ void xcd_barrier_complete(unsigned* bar, unsigned x, unsigned& nloc, unsigned& nx) {
    const unsigned G = gridDim.x * gridDim.y * gridDim.z;
    unsigned sum, cnt, mine, sp = 0u;
    for (;;) {
        sum = 0u; cnt = 0u; mine = 0u;
#pragma unroll
        for (unsigned j = 0; j < 16; ++j) { const unsigned c = xb_ld(&bar[XB_XCNT(j)]); sum += c; cnt += (c > 0u) ? 1u : 0u; mine = (j == x) ? c : mine; }
        if (sum == G) break;
        __builtin_amdgcn_s_sleep(1);
        if ((++sp & 255u) == 0u) { if (xb_ld(&bar[XB_TMO])) break; if (sp > XB_SPIN_CAP) { atomicAdd(&bar[XB_TMO], 1u); break; } }
    }
    nloc = mine > 0u ? mine : 1u; nx = cnt > 0u ? cnt : 1u;
}

__device__ __forceinline__ void xcd_barrier(const XcdBarrier& b) {
    asm volatile("s_waitcnt vmcnt(0)" ::: "memory");
    __syncthreads();
    if (threadIdx.x == 0) {
        unsigned* bar = b.bar;
        __builtin_amdgcn_s_waitcnt(0);
        unsigned nloc = b.st[0], nx = b.st[1];
        if (nloc == 0u) { xcd_barrier_complete(bar, b.x, nloc, nx); b.st[0] = nloc; b.st[1] = nx; }
        const unsigned old = xb_add(&bar[XB_XSUB(b.x)], 1u);
        const unsigned gen = old / nloc;
        if (old + 1u == (gen + 1u) * nloc) {
            __builtin_amdgcn_fence(__ATOMIC_RELEASE, "agent");
            asm volatile("s_waitcnt vmcnt(0)" ::: "memory");
            const unsigned og = xb_add(&bar[XB_TOP], 1u);
            const unsigned tg = og / nx;
            if (og + 1u == (tg + 1u) * nx) xb_add(&bar[XB_TOPGEN], 1u);
            else XB_SPIN(xb_ld(&bar[XB_TOPGEN]) == tg, bar);
            __builtin_amdgcn_fence(__ATOMIC_ACQUIRE, "agent");
            xb_add(&bar[XB_XGEN(b.x)], 1u);
            asm volatile("s_waitcnt vmcnt(0)" ::: "memory");
        } else {
            XB_SPIN(xb_ld(&bar[XB_XGEN(b.x)]) == gen, bar);
            __builtin_amdgcn_fence(__ATOMIC_ACQUIRE, "agent");
            asm volatile("s_waitcnt vmcnt(0)" ::: "memory");
        }
    }
    __syncthreads();
}

constexpr int NWAVES = 8;
constexpr int BATCH = 4, SEQ = 8192, D = 1024, FF = 4096, CTXL = 256, NH = 8, HD = 64, ATT = 512, CONVD = 512, NIN = 2560, NMOD = 6 * D, CW = 31;
constexpr int M = BATCH * SEQ;
constexpr int MC = BATCH * CTXL;
constexpr float EPS = 1e-6f, LOG2E = 1.4426950408889634f;
#ifndef MK_N_LAUNCHES
#define MK_N_LAUNCHES 1
#endif
constexpr int N_PHASES = 8;

constexpr size_t MiB = 1u << 20;
constexpr size_t WS_CTL = 0, CTL_ZERO_BYTES = 64 * 1024;
constexpr size_t WS_MOD = 1 * MiB;
constexpr size_t WS_ROPE = WS_MOD + 128 * 1024;
constexpr size_t WS_S2 = WS_ROPE + 16 * 1024;
constexpr size_t WS_BIAS2 = WS_S2 + 16 * 1024;
constexpr size_t WS_WIN = 2 * MiB, WS_WOUT = 7 * MiB, WS_W1 = 9 * MiB, WS_W2 = 17 * MiB;
constexpr size_t WS_HC = 25 * MiB, WS_KC = 27 * MiB, WS_VC = 28 * MiB, WS_SSQ = 29 * MiB, WS_SSQ2 = 31 * MiB;
constexpr size_t WS_XS = 40 * MiB;
constexpr size_t WS_R = 104 * MiB;
constexpr size_t WS_HX = WS_R, WS_MIX = WS_R, WS_QROT = WS_R + 64 * MiB, WS_Q = WS_R + 96 * MiB, WS_KROT = WS_R + 128 * MiB, WS_V = WS_R + 160 * MiB, WS_HG = WS_R + 192 * MiB;
constexpr size_t WS_HID = WS_R, WS_END = WS_R + 256 * MiB;
constexpr size_t WS_BT = 33 * MiB;
constexpr size_t WS_CP = 360 * MiB;
constexpr size_t WS_END2 = WS_CP + 40 * MiB;
constexpr int CW_BAR = 1024;

constexpr int RING_OFF = 0, RING_BYTES = 153600;
constexpr int LDSCTL_OFF = RING_BYTES, MISC_OFF = LDSCTL_OFF + 320;
constexpr int LDS_BYTES = 163840;

struct Args { const float* in[18]; float* out; unsigned char* ws; int ph_lo, ph_hi; };

struct Frame {
    LAS unsigned char* lds; volatile LAS unsigned* MISC; gu32* ctl;
    int tid, lane, wave, vcu, G;
};
__device__ __forceinline__ float wave_sum(float v) {
#pragma unroll
    for (int o = 1; o < 64; o <<= 1) v += __shfl_xor(v, o);
    return v;
}
__device__ __forceinline__ float wave_max(float v) {
#pragma unroll
    for (int o = 1; o < 64; o <<= 1) v = fmaxf(v, __shfl_xor(v, o));
    return v;
}
__device__ __forceinline__ float bf_lo(unsigned u) { return __builtin_bit_cast(float, u << 16); }
__device__ __forceinline__ float bf_hi(unsigned u) { return __builtin_bit_cast(float, u & 0xffff0000u); }
__device__ __forceinline__ float bf1(bf16 u) { return __builtin_bit_cast(float, (unsigned)u << 16); }

__host__ __device__ __forceinline__ int win_src(int p) {
    if (p < 1024) { const int g = p & ~31, i = p & 31; return g + 16 * ((i >> 2) & 1) + 4 * (i >> 3) + (i & 3); }
    if (p < 1536) return p;
    const int u = p - 1536, t = u >> 8, w = u & 255;
    return w < 128 ? 1536 + 128 * t + w : 2048 + 128 * t + (w - 128);
}
template <bool PERMW>
__device__ __forceinline__ void p0_transpose_item(const float* W, int K, int N, bf16* WT, LAS float* scr, int item, int lane) {
    const int nblk = N / 32, kb = item / nblk, nb = item % nblk, k0 = 64 * kb, n0 = 32 * nb;
    const int sc = PERMW ? win_src(n0 + (lane & 31)) : n0 + (lane & 31);
#pragma unroll 8
    for (int i = 0; i < 32; ++i) { const int kk = 2 * i + (lane >> 5); scr[kk * 33 + (lane & 31)] = W[(size_t)(k0 + kk) * N + sc]; }
    LDS_WAIT(); asm volatile("" ::: "memory");
    const int c = lane & 7;
#pragma unroll
    for (int j = 0; j < 4; ++j) { const int n = (lane >> 3) + 8 * j; const LAS float* s = scr + (8 * c) * 33 + n;
        v4u o; o.x = pk2(s[0 * 33], s[1 * 33]); o.y = pk2(s[2 * 33], s[3 * 33]); o.z = pk2(s[4 * 33], s[5 * 33]); o.w = pk2(s[6 * 33], s[7 * 33]);
        *(GAS v4u*)(WT + (size_t)(n0 + n) * K + k0 + 8 * c) = o; }
    LDS_WAIT(); asm volatile("" ::: "memory");
}
__device__ __forceinline__ float silu_f(float v) { return v / (1.0f + __expf(-v)); }

__device__ __forceinline__ void sincos_small(float a, float& sn, float& cs) {
    const double x = (double)a; const double k = __builtin_rint(x * 0.63661977236758134308); const double r = x - k * 1.57079632679489661923;
    const double r2 = r * r;
    const double s = r * (1.0 + r2 * (-1.0 / 6 + r2 * (1.0 / 120 + r2 * (-1.0 / 5040 + r2 * (1.0 / 362880 + r2 * (-1.0 / 39916800 + r2 * (1.0 / 6227020800.0)))))));
    const double c = 1.0 + r2 * (-0.5 + r2 * (1.0 / 24 + r2 * (-1.0 / 720 + r2 * (1.0 / 40320 + r2 * (-1.0 / 3628800 + r2 * (1.0 / 479001600.0 + r2 * (-1.0 / 87178291200.0)))))));
    const int q = ((int)k) & 3;
    const double ss = (q == 0) ? s : (q == 1) ? c : (q == 2) ? -s : -c;
    const double cc = (q == 0) ? c : (q == 1) ? -s : (q == 2) ? -c : s;
    sn = (float)ss; cs = (float)cc;
}

__device__ __forceinline__ void p0_prologue(Frame& F, const Args& A) {
    unsigned char* ws = A.ws;
    float* MOD = (float*)(ws + WS_MOD);
    if (F.vcu < 96) {
        LAS float* SL = (LAS float*)(F.lds);
        LAS float* RED = (LAS float*)(F.lds + 32768);
        const float* c = A.in[1]; const float* cc = A.in[3];
        for (int u = F.tid; u < 5 * 1024; u += NWAVES * 64) { const int i = u >> 10, k = u & 1023; const float v = (i < 4) ? c[i * 1024 + k] : cc[k]; SL[u] = silu_f(v); }
        __syncthreads();
        const float* Wa = A.in[4]; const int n = F.vcu * 64 + F.lane;
        float a0 = 0.f, a1 = 0.f, a2 = 0.f, a3 = 0.f, a4 = 0.f;
        const int kb = F.wave * 128;
#pragma unroll 8
        for (int k = kb; k < kb + 128; ++k) { const float w = Wa[(size_t)k * NMOD + n];
            a0 += SL[k] * w; a1 += SL[1024 + k] * w; a2 += SL[2048 + k] * w; a3 += SL[3072 + k] * w; a4 += SL[4096 + k] * w; }
        LAS float* r = RED + F.wave * 320 + F.lane;
        r[0] = a0; r[64] = a1; r[128] = a2; r[192] = a3; r[256] = a4;
        __syncthreads();
        if (F.tid < 320) { const int i = F.tid >> 6, l = F.tid & 63; float s = 0.f;
#pragma unroll
            for (int w = 0; w < 8; ++w) s += RED[w * 320 + i * 64 + l];
            MOD[i * NMOD + F.vcu * 64 + l] = s + A.in[5][F.vcu * 64 + l]; }
        __syncthreads();
    } else if (F.vcu < 100) {
        const float invf[16] = {1.0f, 0.5623413324356079f, 0.3162277638912201f, 0.17782793939113617f, 0.10000000149011612f, 0.05623413249850273f, 0.03162277489900589f, 0.017782794311642647f,
                                0.009999999776482582f, 0.005623413249850273f, 0.003162277629598975f, 0.0017782794311642647f, 0.0010000000474974513f, 0.000562341301701963f, 0.0003162277571391314f, 0.00017782794020604342f};
        float* ROPE = (float*)(ws + WS_ROPE);
        const int idx = (F.vcu - 96) * 512 + F.tid, pos = idx >> 4, i = idx & 15;
        float fi = invf[0];
#pragma unroll
        for (int j = 1; j < 16; ++j) fi = (i == j) ? invf[j] : fi;
        const float ang = (float)pos * fi; float sn, cs; sincos_small(ang, sn, cs);
        ROPE[idx * 2] = cs; ROPE[idx * 2 + 1] = sn;
    }
    LAS float* scr = (LAS float*)(F.lds + 40960 + F.wave * 8704);
    const int gw = F.vcu * NWAVES + F.wave, NGW = F.G * NWAVES;
    constexpr int I_IN = (D / 64) * (NIN / 32), I_O = (D / 64) * (D / 32), I_1 = (D / 64) * (FF / 32), I_2 = (FF / 64) * (D / 32);
    constexpr int NITEMS = I_IN + I_O + I_1 + I_2;
    bf16* WIN = (bf16*)(ws + WS_WIN); bf16* WOUT = (bf16*)(ws + WS_WOUT); bf16* W1 = (bf16*)(ws + WS_W1); bf16* W2 = (bf16*)(ws + WS_W2);
    for (int it = gw; it < NITEMS; it += NGW) {
        int r = it;
        if (r < I_IN) { p0_transpose_item<true>(A.in[8], D, NIN, WIN, scr, r, F.lane); continue; } r -= I_IN;
        if (r < I_O) { p0_transpose_item<false>(A.in[14], D, D, WOUT, scr, r, F.lane); continue; } r -= I_O;
        if (r < I_1) { p0_transpose_item<false>(A.in[15], D, FF, W1, scr, r, F.lane); continue; } r -= I_1;
        p0_transpose_item<false>(A.in[16], FF, D, W2, scr, r, F.lane);
    }
}

__device__ __forceinline__ void norm_mod_row(Frame& F, const float* xrow, bf16* orow, const float* g, const float* sh, const float* sc) {
    const GAS f32x4* xr = (const GAS f32x4*)xrow + F.lane;
    f32x4 v[4]; float s = 0.f;
#pragma unroll
    for (int j = 0; j < 4; ++j) { v[j] = xr[64 * j]; s += (v[j].x * v[j].x + v[j].y * v[j].y) + (v[j].z * v[j].z + v[j].w * v[j].w); }
    const float rstd = 1.0f / sqrtf(wave_sum(s) * (1.f / D) + EPS);
    GAS unsigned long long* o8 = (GAS unsigned long long*)orow + F.lane;
#pragma unroll
    for (int j = 0; j < 4; ++j) { const f32x4 gv = ((const f32x4*)g)[64 * j + F.lane], shv = ((const f32x4*)sh)[64 * j + F.lane], scv = ((const f32x4*)sc)[64 * j + F.lane];
        const f32x4 y = (v[j] * rstd * gv) * (scv + 1.0f) + shv;
        o8[64 * j] = (unsigned long long)pk2(y.x, y.y) | ((unsigned long long)pk2(y.z, y.w) << 32); }
}
__device__ __forceinline__ void p1_norm(Frame& F, const Args& A) {
    unsigned char* ws = A.ws; const float* MOD = (const float*)(ws + WS_MOD);
    const int gw = F.vcu * NWAVES + F.wave, NGW = F.G * NWAVES;
    bf16* HX = (bf16*)(ws + WS_HX); bf16* HC = (bf16*)(ws + WS_HC);
    for (int m = gw; m < M + MC; m += NGW) {
        if (m < M) { const int b = m >> 13; norm_mod_row(F, A.in[0] + (size_t)m * D, HX + (size_t)m * D, A.in[6], MOD + b * NMOD, MOD + b * NMOD + D); }
        else { const int mc = m - M; norm_mod_row(F, A.in[2] + (size_t)mc * D, HC + (size_t)mc * D, A.in[6], MOD + 4 * NMOD, MOD + 4 * NMOD + D); }
    }
    if (F.vcu == 0) { float* S2 = (float*)(ws + WS_S2);
        for (int u = F.tid; u < 4 * D; u += NWAVES * 64) { const int b = u >> 10, k = u & 1023; S2[u] = A.in[7][k] * (1.0f + MOD[b * NMOD + 4 * D + k]); } }
    const bf16* W1 = (const bf16*)(ws + WS_W1); float* B2 = (float*)(ws + WS_BIAS2);
    for (int n = gw; n < FF; n += NGW) {
        const v4u* wp = (const v4u*)(W1 + (size_t)n * D + 16 * F.lane); const v4u w0 = wp[0], w1 = wp[1];
        float wf[16] = {bf_lo(w0.x), bf_hi(w0.x), bf_lo(w0.y), bf_hi(w0.y), bf_lo(w0.z), bf_hi(w0.z), bf_lo(w0.w), bf_hi(w0.w),
                        bf_lo(w1.x), bf_hi(w1.x), bf_lo(w1.y), bf_hi(w1.y), bf_lo(w1.z), bf_hi(w1.z), bf_lo(w1.w), bf_hi(w1.w)};
#pragma unroll
        for (int b = 0; b < 4; ++b) { const f32x4* sp = (const f32x4*)(MOD + b * NMOD + 3 * D + 16 * F.lane); float s = 0.f;
#pragma unroll
            for (int q = 0; q < 4; ++q) { const f32x4 sv = sp[q]; s += (sv.x * wf[4 * q] + sv.y * wf[4 * q + 1]) + (sv.z * wf[4 * q + 2] + sv.w * wf[4 * q + 3]); }
            s = wave_sum(s); if (F.lane == 0) B2[b * FF + n] = s; }
    }
}

__device__ __forceinline__ float dot8(v4u a, v4u b) {
    return (bf_lo(a.x) * bf_lo(b.x) + bf_hi(a.x) * bf_hi(b.x)) + (bf_lo(a.y) * bf_lo(b.y) + bf_hi(a.y) * bf_hi(b.y)) + (bf_lo(a.z) * bf_lo(b.z) + bf_hi(a.z) * bf_hi(b.z)) + (bf_lo(a.w) * bf_lo(b.w) + bf_hi(a.w) * bf_hi(b.w));
}
__device__ __forceinline__ void p3_attn_naive(Frame& F, const Args& A) {
    unsigned char* ws = A.ws;
    const bf16* QROT = (const bf16*)(ws + WS_QROT); const bf16* Q = (const bf16*)(ws + WS_Q); const bf16* KROT = (const bf16*)(ws + WS_KROT); const bf16* V = (const bf16*)(ws + WS_V);
    const bf16* KC = (const bf16*)(ws + WS_KC); const bf16* VC = (const bf16*)(ws + WS_VC); bf16* MIX = (bf16*)(ws + WS_MIX);
    const float* rpb = A.in[13];
    LAS float* pbuf = (LAS float*)(F.lds) + F.wave * 384;
    const int gw = F.vcu * NWAVES + F.wave, NGW = F.G * NWAVES, lane = F.lane;
    for (int item = gw; item < M * NH; item += NGW) {
        const int row = item >> 3, h = item & 7, b = row >> 13, t = row & 8191, r = t >> 6, c = t & 63;
        const int rs = min(max(r - 4, 0), 120), cs = min(max(c - 8, 0), 48);
        const v4u* qrp = (const v4u*)(QROT + (size_t)row * ATT + h * HD); const v4u* qp = (const v4u*)(Q + (size_t)row * ATT + h * HD);
        float s[6];
#pragma unroll
        for (int j = 0; j < 2; ++j) { const int w = lane + 64 * j, i = w >> 4, jc = w & 15; const size_t kt = (size_t)b * SEQ + (rs + i) * 64 + cs + jc;
            const v4u* kp = (const v4u*)(KROT + kt * ATT + h * HD); float d = 0.f;
#pragma unroll
            for (int e = 0; e < 8; ++e) d += dot8(qrp[e], kp[e]);
            s[j] = d + rpb[h * 465 + (rs + i - r + 7) * 31 + (cs + jc - c + 15)] * LOG2E; }
#pragma unroll
        for (int j = 0; j < 4; ++j) { const int ci = lane + 64 * j; const v4u* kp = (const v4u*)(KC + (size_t)(b * CTXL + ci) * ATT + h * HD); float d = 0.f;
#pragma unroll
            for (int e = 0; e < 8; ++e) d += dot8(qp[e], kp[e]);
            s[2 + j] = d; }
        float mx = fmaxf(fmaxf(fmaxf(s[0], s[1]), fmaxf(s[2], s[3])), fmaxf(s[4], s[5])); mx = wave_max(mx);
        float l = 0.f;
#pragma unroll
        for (int j = 0; j < 6; ++j) { s[j] = __builtin_amdgcn_exp2f(s[j] - mx); l += s[j]; pbuf[lane + 64 * j] = s[j]; }
        l = wave_sum(l);
        LDS_WAIT(); asm volatile("" ::: "memory");
        float o = 0.f;
#pragma unroll 8
        for (int w = 0; w < 128; ++w) { const int i = w >> 4, jc = w & 15; const size_t kt = (size_t)b * SEQ + (rs + i) * 64 + cs + jc; o += pbuf[w] * bf1(V[kt * ATT + h * HD + lane]); }
#pragma unroll 8
        for (int ci = 0; ci < CTXL; ++ci) o += pbuf[128 + ci] * bf1(VC[(size_t)(b * CTXL + ci) * ATT + h * HD + lane]);
        MIX[(size_t)row * D + h * HD + lane] = (bf16)f2bf(o / l);
        LDS_WAIT(); asm volatile("" ::: "memory");
    }
}
#if defined(DBG_E1)
__device__ __forceinline__ void p3_attn_dbg_e1(Frame& F, const Args& A) {
    unsigned char* ws = A.ws;
    const bf16* QROT = (const bf16*)(ws + WS_QROT); const bf16* KROT = (const bf16*)(ws + WS_KROT); const bf16* V = (const bf16*)(ws + WS_V); bf16* MIX = (bf16*)(ws + WS_MIX);
    const unsigned* CP = (const unsigned*)(ws + WS_CP);
    const float* rpb = A.in[13];
    LAS float* pbuf = (LAS float*)(F.lds) + F.wave * 384;
    const int gw = F.vcu * NWAVES + F.wave, NGW = F.G * NWAVES, lane = F.lane;
    for (int item = gw; item < M * NH; item += NGW) {
        const int row = item >> 3, h = item & 7, b = row >> 13, t = row & 8191, r = t >> 6, c = t & 63;
        const int rs = min(max(r - 4, 0), 120), cs = min(max(c - 8, 0), 48);
        const v4u* qrp = (const v4u*)(QROT + (size_t)row * ATT + h * HD);
        float s[2];
#pragma unroll
        for (int j = 0; j < 2; ++j) { const int w = lane + 64 * j, i = w >> 4, jc = w & 15; const size_t kt = (size_t)b * SEQ + (rs + i) * 64 + cs + jc;
            const v4u* kp = (const v4u*)(KROT + kt * ATT + h * HD); float d = 0.f;
#pragma unroll
            for (int e = 0; e < 8; ++e) d += dot8(qrp[e], kp[e]);
            s[j] = d + rpb[h * 465 + (rs + i - r + 7) * 31 + (cs + jc - c + 15)] * LOG2E; }
        float mw = wave_max(fmaxf(s[0], s[1]));
        float lw = 0.f;
#pragma unroll
        for (int j = 0; j < 2; ++j) { s[j] = __builtin_amdgcn_exp2f(s[j] - mw); lw += s[j]; pbuf[lane + 64 * j] = s[j]; }
        lw = wave_sum(lw);
        LDS_WAIT(); asm volatile("" ::: "memory");
        float o = 0.f;
#pragma unroll 8
        for (int w = 0; w < 128; ++w) { const int i = w >> 4, jc = w & 15; const size_t kt = (size_t)b * SEQ + (rs + i) * 64 + cs + jc; o += pbuf[w] * bf1(V[kt * ATT + h * HD + lane]); }
        const int band = r >> 4, stp = (r & 15) >> 2, cg = c >> 4, wv = 2 * (r & 3) + (cg & 1), us = (cg >> 1) * 4 + stp, n = c & 15, d = lane;
        const size_t uidx = ((((size_t)(b * 8 + h) * 8 + band) * 8 + wv) * 8 + us);
        const unsigned pw = CP[uidx * 640 + (2 * (d >> 4) + ((d & 3) >> 1)) * 64 + (n + 16 * ((d >> 2) & 3))];
        const float oc = (d & 1) ? bf_hi(pw) : bf_lo(pw);
        const float mc = __builtin_bit_cast(float, CP[uidx * 640 + 8 * 64 + n]), lc = __builtin_bit_cast(float, CP[uidx * 640 + 9 * 64 + n]);
        const float mm = fmaxf(mc, mw), ac = __builtin_amdgcn_exp2f(mc - mm), aw = __builtin_amdgcn_exp2f(mw - mm);
        MIX[(size_t)row * D + h * HD + lane] = (bf16)f2bf((oc * ac + o * aw) / (lc * ac + lw * aw));
        LDS_WAIT(); asm volatile("" ::: "memory");
    }
}
#endif
#if defined(DBG_E3)
__device__ __forceinline__ void p3_attn_dbg_e3(Frame& F, const Args& A) {
    unsigned char* ws = A.ws;
    const bf16* Q = (const bf16*)(ws + WS_Q); const bf16* KC = (const bf16*)(ws + WS_KC); const bf16* VC = (const bf16*)(ws + WS_VC); bf16* MIX = (bf16*)(ws + WS_MIX);
    const unsigned* CP = (const unsigned*)(ws + WS_CP);
    LAS float* pbuf = (LAS float*)(F.lds) + F.wave * 384;
    const int gw = F.vcu * NWAVES + F.wave, NGW = F.G * NWAVES, lane = F.lane;
    for (int item = gw; item < M * NH; item += NGW) {
        const int row = item >> 3, h = item & 7, b = row >> 13, t = row & 8191, r = t >> 6, c = t & 63;
        const v4u* qp = (const v4u*)(Q + (size_t)row * ATT + h * HD);
        float s[4];
#pragma unroll
        for (int j = 0; j < 4; ++j) { const int ci = lane + 64 * j; const v4u* kp = (const v4u*)(KC + (size_t)(b * CTXL + ci) * ATT + h * HD); float d = 0.f;
#pragma unroll
            for (int e = 0; e < 8; ++e) d += dot8(qp[e], kp[e]);
            s[j] = d; }
        float mcx = wave_max(fmaxf(fmaxf(s[0], s[1]), fmaxf(s[2], s[3])));
        float lcx = 0.f;
#pragma unroll
        for (int j = 0; j < 4; ++j) { s[j] = __builtin_amdgcn_exp2f(s[j] - mcx); lcx += s[j]; pbuf[lane + 64 * j] = s[j]; }
        lcx = wave_sum(lcx);
        LDS_WAIT(); asm volatile("" ::: "memory");
        float o = 0.f;
#pragma unroll 8
        for (int ci = 0; ci < CTXL; ++ci) o += pbuf[ci] * bf1(VC[(size_t)(b * CTXL + ci) * ATT + h * HD + lane]);
        const int band = r >> 4, stp = (r & 15) >> 2, cg = c >> 4, wv = 2 * (r & 3) + (cg & 1), us = (cg >> 1) * 4 + stp, n = c & 15, d = lane;
        const size_t uidx = ((((size_t)(b * 8 + h) * 8 + band) * 8 + wv) * 8 + us);
        const unsigned pw = CP[uidx * 640 + (2 * (d >> 4) + ((d & 3) >> 1)) * 64 + (n + 16 * ((d >> 2) & 3))];
        const float ow = (d & 1) ? bf_hi(pw) : bf_lo(pw);
        const float mw = __builtin_bit_cast(float, CP[uidx * 640 + 8 * 64 + n]), lw = __builtin_bit_cast(float, CP[uidx * 640 + 9 * 64 + n]);
        const float mm = fmaxf(mcx, mw), ac = __builtin_amdgcn_exp2f(mcx - mm), aw = __builtin_amdgcn_exp2f(mw - mm);
        MIX[(size_t)row * D + h * HD + lane] = (bf16)f2bf((o * ac + ow * aw) / (lcx * ac + lw * aw));
        LDS_WAIT(); asm volatile("" ::: "memory");
    }
}
#endif
__device__ __forceinline__ void p3_conv_naive(Frame& F, const Args& A) {
    unsigned char* ws = A.ws; const bf16* HG = (const bf16*)(ws + WS_HG); bf16* MIX = (bf16*)(ws + WS_MIX);
    const float* dwk = A.in[9]; const float* dwb = A.in[10]; const float* lg = A.in[11]; const float* lb = A.in[12];
    const int gw = F.vcu * NWAVES + F.wave, NGW = F.G * NWAVES, c0 = F.lane * 8;
    for (int row = gw; row < M; row += NGW) {
        const int b = row >> 13, t = row & 8191;
        const f32x4 b0 = *(const f32x4*)(dwb + c0), b1 = *(const f32x4*)(dwb + c0 + 4);
        float a[8] = {b0.x, b0.y, b0.z, b0.w, b1.x, b1.y, b1.z, b1.w};
        for (int j = 0; j < CW; ++j) { const int tt = t + j - 15; if (tt < 0 || tt >= SEQ) continue;
            const v4u hv = *(const v4u*)(HG + (size_t)(b * SEQ + tt) * CONVD + c0); const f32x4 k0 = *(const f32x4*)(dwk + j * CONVD + c0), k1 = *(const f32x4*)(dwk + j * CONVD + c0 + 4);
            a[0] += bf_lo(hv.x) * k0.x; a[1] += bf_hi(hv.x) * k0.y; a[2] += bf_lo(hv.y) * k0.z; a[3] += bf_hi(hv.y) * k0.w;
            a[4] += bf_lo(hv.z) * k1.x; a[5] += bf_hi(hv.z) * k1.y; a[6] += bf_lo(hv.w) * k1.z; a[7] += bf_hi(hv.w) * k1.w; }
        float s = 0.f;
#pragma unroll
        for (int e = 0; e < 8; ++e) s += a[e];
        const float mean = wave_sum(s) * (1.f / CONVD); float q = 0.f;
#pragma unroll
        for (int e = 0; e < 8; ++e) { a[e] -= mean; q += a[e] * a[e]; }
        const float rstd = 1.0f / sqrtf(wave_sum(q) * (1.f / CONVD) + EPS);
        const f32x4 g0 = *(const f32x4*)(lg + c0), g1 = *(const f32x4*)(lg + c0 + 4), e0 = *(const f32x4*)(lb + c0), e1 = *(const f32x4*)(lb + c0 + 4);
        const float gg[8] = {g0.x, g0.y, g0.z, g0.w, g1.x, g1.y, g1.z, g1.w}, bb[8] = {e0.x, e0.y, e0.z, e0.w, e1.x, e1.y, e1.z, e1.w};
        float y[8];
#pragma unroll
        for (int e = 0; e < 8; ++e) { const float v = a[e] * rstd * gg[e] + bb[e]; y[e] = silu_f(v); }
        v4u o; o.x = pk2(y[0], y[1]); o.y = pk2(y[2], y[3]); o.z = pk2(y[4], y[5]); o.w = pk2(y[6], y[7]);
        *(GAS v4u*)(MIX + (size_t)row * D + ATT + c0) = o;
    }
}

__device__ __forceinline__ void p7_final(Frame& F, const Args& A) {
    const float* SSQ2 = (const float*)(A.ws + WS_SSQ2); const float* fg = A.in[17];
    const int gw = F.vcu * NWAVES + F.wave, NGW = F.G * NWAVES;
    for (int m = gw; m < M; m += NGW) {
        const float pv = (F.lane < 16) ? SSQ2[(size_t)m * 16 + F.lane] : 0.f;
        const float rstd = 1.0f / sqrtf(wave_sum(pv) * (1.f / D) + EPS);
        GAS f32x4* xr = (GAS f32x4*)(A.out + (size_t)m * D) + F.lane;
#pragma unroll
        for (int j = 0; j < 4; ++j) { const f32x4 gv = ((const f32x4*)fg)[64 * j + F.lane]; xr[64 * j] = xr[64 * j] * rstd * gv; }
    }
}


typedef short s16x4 __attribute__((ext_vector_type(4)));
typedef short v4i16_t __attribute__((ext_vector_type(4)));
constexpr int RSLOT = 10240, RSLOTS = 15;

__device__ __forceinline__ s16x4 vtr16(LAS const unsigned char* p) { return __builtin_bit_cast(s16x4, __builtin_amdgcn_ds_read_tr16_b64_v4i16((LAS v4i16_t*)p)); }
__device__ __forceinline__ unsigned cvtpk(float lo, float hi) { typedef float f2 __attribute__((ext_vector_type(2))); typedef __bf16 b2 __attribute__((ext_vector_type(2))); f2 v = {lo, hi}; b2 b = __builtin_convertvector(v, b2); return __builtin_bit_cast(unsigned, b); }

struct BlkA { __device__ __forceinline__ int k(int kb) const { return kb * 2048; } __device__ __forceinline__ int v(int kb) const { return 32768 + kb * 2048; } };
struct BlkB { int s0, coff;
    __device__ __forceinline__ int slot(int iw) const { const int s = s0 + iw; return s >= RSLOTS ? s - RSLOTS : s; }
    __device__ __forceinline__ int k(int kb) const { return slot(kb >> 1) * RSLOT + (coff + 16 * (kb & 1)) * 128; }
    __device__ __forceinline__ int v(int kb) const { return slot(kb >> 1) * RSLOT + 5120 + (coff + 16 * (kb & 1)) * 128; } };

template <class Blk>
__device__ __forceinline__ void attn_unit(LAS const unsigned char* lds, const Blk& B, bf16x8 q0, bf16x8 q1, f32x4 (&S)[16], int kofs0, int kofs1, const int (&vofs)[4], float m0, float l0, float& m, float& l, f32x4 (&o)[4]) {
    bf16x8 kfa[8], kfb[8];
#define AT_LOADK(dst, grp) do { _Pragma("unroll") for (int j = 0; j < 4; ++j) { const int kbase = B.k(4 * (grp) + j); dst[2 * j] = *(const LAS bf16x8*)(lds + kbase + kofs0); dst[2 * j + 1] = *(const LAS bf16x8*)(lds + kbase + kofs1); } } while (0)
#define AT_MMAK(src, grp) do { _Pragma("unroll") for (int j = 0; j < 4; ++j) { S[4 * (grp) + j] = __builtin_amdgcn_mfma_f32_16x16x32_bf16(src[2 * j], q0, S[4 * (grp) + j], 0, 0, 0); S[4 * (grp) + j] = __builtin_amdgcn_mfma_f32_16x16x32_bf16(src[2 * j + 1], q1, S[4 * (grp) + j], 0, 0, 0); } } while (0)
    AT_LOADK(kfa, 0); __builtin_amdgcn_sched_barrier(0);
    AT_LOADK(kfb, 1); __builtin_amdgcn_sched_barrier(0); AT_MMAK(kfa, 0); __builtin_amdgcn_sched_barrier(0);
    AT_LOADK(kfa, 2); __builtin_amdgcn_sched_barrier(0); AT_MMAK(kfb, 1); __builtin_amdgcn_sched_barrier(0);
    AT_LOADK(kfb, 3); __builtin_amdgcn_sched_barrier(0); AT_MMAK(kfa, 2); __builtin_amdgcn_sched_barrier(0);
    AT_MMAK(kfb, 3); __builtin_amdgcn_sched_barrier(0);
#undef AT_LOADK
#undef AT_MMAK
    float mx = fmaxf(fmaxf(S[0][0], S[0][1]), fmaxf(S[0][2], S[0][3]));
#pragma unroll
    for (int kb = 1; kb < 16; ++kb) mx = fmaxf(mx, fmaxf(fmaxf(S[kb][0], S[kb][1]), fmaxf(S[kb][2], S[kb][3])));
    mx = fmaxf(mx, __shfl_xor(mx, 16)); mx = fmaxf(mx, __shfl_xor(mx, 32));
    mx = fmaxf(mx, m0);
    const float alpha = __builtin_amdgcn_exp2f(m0 - mx);
    s16x4 vfa[8], vfb[8];
#define AT_LOADV(dst, s) do { const int v0_ = B.v(2 * (s)), v1_ = B.v(2 * (s) + 1); _Pragma("unroll") for (int db = 0; db < 4; ++db) { dst[2 * db] = vtr16(lds + v0_ + vofs[db]); dst[2 * db + 1] = vtr16(lds + v1_ + vofs[db]); } } while (0)
#define AT_EXP(s) do { _Pragma("unroll") for (int e = 0; e < 4; ++e) { S[2 * (s)][e] = __builtin_amdgcn_exp2f(S[2 * (s)][e] - mx); S[2 * (s) + 1][e] = __builtin_amdgcn_exp2f(S[2 * (s) + 1][e] - mx); } \
        sum += ((S[2 * (s)][0] + S[2 * (s)][1]) + (S[2 * (s)][2] + S[2 * (s)][3])) + ((S[2 * (s) + 1][0] + S[2 * (s) + 1][1]) + (S[2 * (s) + 1][2] + S[2 * (s) + 1][3])); asm volatile("" : "+v"(sum)); } while (0)
#define AT_MMAV(src, s) do { v4u pw; pw.x = cvtpk(S[2 * (s)][0], S[2 * (s)][1]); pw.y = cvtpk(S[2 * (s)][2], S[2 * (s)][3]); pw.z = cvtpk(S[2 * (s) + 1][0], S[2 * (s) + 1][1]); pw.w = cvtpk(S[2 * (s) + 1][2], S[2 * (s) + 1][3]); \
        const bf16x8 pb = __builtin_bit_cast(bf16x8, pw); \
        _Pragma("unroll") for (int db = 0; db < 4; ++db) { const s16x4 lo = src[2 * db], hi = src[2 * db + 1]; const bf16x8 va = {lo[0], lo[1], lo[2], lo[3], hi[0], hi[1], hi[2], hi[3]}; \
            o[db] = __builtin_amdgcn_mfma_f32_16x16x32_bf16(va, pb, o[db], 0, 0, 0); } } while (0)
    float sum = 0.f;
#pragma unroll
    for (int db = 0; db < 4; ++db) o[db] = o[db] * alpha;
    AT_LOADV(vfa, 0); AT_EXP(0); __builtin_amdgcn_sched_barrier(0);
    AT_LOADV(vfb, 1); AT_EXP(1); __builtin_amdgcn_sched_barrier(0); AT_MMAV(vfa, 0); __builtin_amdgcn_sched_barrier(0);
    AT_LOADV(vfa, 2); AT_EXP(2); __builtin_amdgcn_sched_barrier(0); AT_MMAV(vfb, 1); __builtin_amdgcn_sched_barrier(0);
    AT_LOADV(vfb, 3); AT_EXP(3); __builtin_amdgcn_sched_barrier(0); AT_MMAV(vfa, 2); __builtin_amdgcn_sched_barrier(0);
    AT_LOADV(vfa, 4); AT_EXP(4); __builtin_amdgcn_sched_barrier(0); AT_MMAV(vfb, 3); __builtin_amdgcn_sched_barrier(0);
    AT_LOADV(vfb, 5); AT_EXP(5); __builtin_amdgcn_sched_barrier(0); AT_MMAV(vfa, 4); __builtin_amdgcn_sched_barrier(0);
    AT_LOADV(vfa, 6); AT_EXP(6); __builtin_amdgcn_sched_barrier(0); AT_MMAV(vfb, 5); __builtin_amdgcn_sched_barrier(0);
    AT_LOADV(vfb, 7); AT_EXP(7); __builtin_amdgcn_sched_barrier(0); AT_MMAV(vfa, 6); __builtin_amdgcn_sched_barrier(0);
    AT_MMAV(vfb, 7); __builtin_amdgcn_sched_barrier(0);
#undef AT_LOADV
#undef AT_EXP
#undef AT_MMAV
    sum += __shfl_xor(sum, 16); sum += __shfl_xor(sum, 32);
    m = mx; l = sum + l0 * alpha;
}

__device__ __forceinline__ void p0_bias_tiles(Frame& F, const Args& A) {
    const float* rpb = A.in[13]; float* BT = (float*)(A.ws + WS_BT);
    const int gw = F.vcu * NWAVES + F.wave, NGW = F.G * NWAVES, n = F.lane & 15, g = F.lane >> 4;
    for (int t = gw; t < NH * 4 * 2 * 15; t += NGW) {
        const int ro = t % 15, jh = (t / 15) & 1, cg = (t / 30) & 3, h = t / 120;
        const int c0 = 16 * cg, kc0 = min(max(c0 - 8, 0), 32), c = c0 + n, cs = min(max(c - 8, 0), 48);
        f32x4 v;
#pragma unroll
        for (int e = 0; e < 4; ++e) { const int kc = kc0 + 16 * jh + 4 * g + e; const bool ok = (kc >= cs) && (kc <= cs + 15);
            v[e] = ok ? rpb[h * 465 + ro * 31 + (kc - c + 15)] * LOG2E : -1.0e30f; }
        *(f32x4*)(BT + (size_t)t * 256 + F.lane * 4) = v;
    }
}

__device__ __forceinline__ void p3_attention(Frame& F, const Args& A) {
    unsigned char* ws = A.ws;
    const bf16* QROT = (const bf16*)(ws + WS_QROT); const bf16* Q = (const bf16*)(ws + WS_Q); const bf16* KROT = (const bf16*)(ws + WS_KROT); const bf16* V = (const bf16*)(ws + WS_V);
    const bf16* KC = (const bf16*)(ws + WS_KC); const bf16* VC = (const bf16*)(ws + WS_VC); bf16* MIX = (bf16*)(ws + WS_MIX);
    const float* BT = (const float*)(ws + WS_BT); unsigned* CP = (unsigned*)(ws + WS_CP);
    LAS unsigned char* lds = F.lds;
    const int lane = F.lane, w = F.wave, n = lane & 15, g = lane >> 4;
    const int kofs0 = n * 128 + (((0 + g) ^ (n & 7)) * 16), kofs1 = n * 128 + (((4 + g) ^ (n & 7)) * 16);
    const int tq = (lane & 15) >> 2, tp = lane & 3, trow = 4 * g + tq, tsw = ((trow & 7) >> 1) & 3;
    int vofs[4];
#pragma unroll
    for (int db = 0; db < 4; ++db) vofs[db] = trow * 128 + ((db ^ tsw) * 32) + 8 * tp;

    for (int item = F.vcu; item < BATCH * NH * 8; item += F.G) {
        const int band = item & 7, h = (item >> 3) & 7, b = item >> 6, r0 = 16 * band;
        const size_t tokb = (size_t)b * SEQ;
        __syncthreads();
#pragma unroll
        for (int j = 0; j < 4; ++j) { const int u = F.tid + 512 * j, key = u >> 3, pc = u & 7;
            const v4u kv = *(const v4u*)(KC + (size_t)(b * CTXL + key) * ATT + h * HD + (pc ^ (key & 7)) * 8);
            const int sseg = (pc >> 1) ^ ((key >> 1) & 3);
            const v4u vv = *(const v4u*)(VC + (size_t)(b * CTXL + key) * ATT + h * HD + (sseg * 2 + (pc & 1)) * 8);
            *(LAS v4u*)(lds + key * 128 + pc * 16) = kv; *(LAS v4u*)(lds + 32768 + key * 128 + pc * 16) = vv; }
        __syncthreads();
        const size_t ubase = ((size_t)item * 8 + w) * 8;
        for (int us = 0; us < 8; ++us) {
            const int half = us >> 2, step = us & 3, row = r0 + 4 * step + (w >> 1), cg = 2 * half + (w & 1);
            const size_t tok = tokb + row * 64 + 16 * cg + n;
            const bf16x8 q0 = *(const bf16x8*)(Q + tok * ATT + h * HD + 8 * g), q1 = *(const bf16x8*)(Q + tok * ATT + h * HD + 32 + 8 * g);
            f32x4 S[16];
#pragma unroll
            for (int kb = 0; kb < 16; ++kb) S[kb] = (f32x4){0.f, 0.f, 0.f, 0.f};
            float m, l; f32x4 o[4];
#pragma unroll
            for (int db = 0; db < 4; ++db) o[db] = (f32x4){0.f, 0.f, 0.f, 0.f};
            attn_unit<BlkA>(lds, BlkA{}, q0, q1, S, kofs0, kofs1, vofs, -1.0e30f, 0.f, m, l, o);
            unsigned* cp = CP + (ubase + us) * 640 + lane;
#pragma unroll
            for (int db = 0; db < 4; ++db) { cp[(2 * db) * 64] = cvtpk(o[db][0], o[db][1]); cp[(2 * db + 1) * 64] = cvtpk(o[db][2], o[db][3]); }
            cp[8 * 64] = __builtin_bit_cast(unsigned, m); cp[9 * 64] = __builtin_bit_cast(unsigned, l);
        }
#if defined(DBG_E1)
        if (true) continue;
#endif
        for (int half = 0; half < 2; ++half) {
            const int hb = 24 * half; int have_hi = -1;
            const int cg = 2 * half + (w & 1), coff = 8 * (w & 1);
            for (int step = 0; step < 4; ++step) {
                const int rf = r0 + 4 * step;
                const int need_lo = min(max(rf - 4, 0), 120), need_hi = min(max(rf + 3 - 4, 0), 120) + 7;
                auto issue_rows = [&](int lo, int hi) {
                    const int cnt = (hi - lo + 1) * 10;
                    for (int it = w; it < cnt; it += NWAVES) {
                        const int rr = lo + it / 10, part = it % 10, isv = part >= 5 ? 1 : 0, cb = (part - 5 * isv) * 8;
                        const int kk = lane >> 3, pc = lane & 7;
                        const size_t tk = tokb + rr * 64 + hb + cb + kk;
                        const int sch = isv ? ((((pc >> 1) ^ ((kk >> 1) & 3)) * 2) + (pc & 1)) : (pc ^ kk);
                        const bf16* src = (isv ? V : KROT) + tk * ATT + h * HD + sch * 8;
                        const int dst = (rr % RSLOTS) * RSLOT + isv * 5120 + cb * 128;
#if defined(RING_REGSTAGE)
                        { const v4u tv = *(const v4u*)src; *(LAS v4u*)(lds + dst + lane * 16) = tv; }
#else
                        __builtin_amdgcn_global_load_lds((const unsigned*)src, (LAS unsigned*)(lds + dst), 16, 0, 0);
#endif
                    }
                };
                if (step == 0) {
                    __syncthreads();
                    issue_rows(need_lo, need_hi); have_hi = need_hi;
                    asm volatile("s_waitcnt vmcnt(0)" ::: "memory"); __syncthreads();
                }
                const int row = rf + (w >> 1), rs = min(max(row - 4, 0), 120);
                const size_t tok = tokb + row * 64 + 16 * cg + n;
                const bf16x8 q0 = *(const bf16x8*)(QROT + tok * ATT + h * HD + 8 * g), q1 = *(const bf16x8*)(QROT + tok * ATT + h * HD + 32 + 8 * g);
                f32x4 S[16];
#pragma unroll
                for (int kb = 0; kb < 16; ++kb) { const int ro = rs + (kb >> 1) - row + 7; S[kb] = *(const f32x4*)(BT + ((size_t)(((h * 4 + cg) * 2 + (kb & 1)) * 15 + ro)) * 256 + lane * 4); }
                const unsigned* cp = CP + (ubase + half * 4 + step) * 640 + lane;
                f32x4 o[4];
#pragma unroll
                for (int db = 0; db < 4; ++db) { const unsigned a0 = cp[(2 * db) * 64], a1 = cp[(2 * db + 1) * 64]; o[db] = (f32x4){bf_lo(a0), bf_hi(a0), bf_lo(a1), bf_hi(a1)}; }
                float mc = __builtin_bit_cast(float, cp[8 * 64]), lc = __builtin_bit_cast(float, cp[9 * 64]);
#pragma unroll
                for (int kb = 0; kb < 16; ++kb) asm volatile("" : "+v"(S[kb]));
                asm volatile("" : "+v"(o[0]), "+v"(o[1]), "+v"(o[2]), "+v"(o[3]), "+v"(mc), "+v"(lc));
                bf16x8 q0r = q0, q1r = q1; asm volatile("" : "+v"(q0r), "+v"(q1r));
                if (step < 3) { const int nhi = min(max(rf + 7 - 4, 0), 120) + 7; if (nhi > have_hi) { issue_rows(have_hi + 1, nhi); have_hi = nhi; } }
                float mw, lw;
                BlkB blk; blk.s0 = rs % RSLOTS; blk.coff = coff;
#if defined(DBG_E3)
#pragma unroll
                for (int db = 0; db < 4; ++db) o[db] = (f32x4){0.f, 0.f, 0.f, 0.f};
                attn_unit<BlkB>(lds, blk, q0r, q1r, S, kofs0, kofs1, vofs, -1.0e30f, 0.f, mw, lw, o);
                { unsigned* cpw = CP + (ubase + half * 4 + step) * 640 + lane;
#pragma unroll
                  for (int db = 0; db < 4; ++db) { cpw[(2 * db) * 64] = cvtpk(o[db][0], o[db][1]); cpw[(2 * db + 1) * 64] = cvtpk(o[db][2], o[db][3]); }
                  cpw[8 * 64] = __builtin_bit_cast(unsigned, mw); cpw[9 * 64] = __builtin_bit_cast(unsigned, lw); }
#else
                attn_unit<BlkB>(lds, blk, q0r, q1r, S, kofs0, kofs1, vofs, mc, lc, mw, lw, o);
#endif
                const float inv = 1.0f / lw;
                bf16* op = MIX + tok * D + h * HD + 4 * g;
#pragma unroll
                for (int db = 0; db < 4; ++db) {
                    typedef unsigned u2 __attribute__((ext_vector_type(2))); u2 wv; wv.x = cvtpk(o[db][0] * inv, o[db][1] * inv); wv.y = cvtpk(o[db][2] * inv, o[db][3] * inv);
                    *(u2*)(op + 16 * db) = wv;
                }
                asm volatile("s_waitcnt vmcnt(0)" ::: "memory"); __syncthreads();
            }
        }
    }
}
__global__ void __launch_bounds__(NWAVES * 64, 2) hymba_fwd(Args args) {
    extern __shared__ __attribute__((aligned(16))) unsigned char lds[];
    Frame F;
    F.lds = (LAS unsigned char*)lds;
    F.MISC = (volatile LAS unsigned*)(F.lds + MISC_OFF);
    F.tid = threadIdx.x; F.lane = F.tid & 63; F.wave = __builtin_amdgcn_readfirstlane(F.tid >> 6);
    F.G = gridDim.x; { const int bx = blockIdx.x; F.vcu = (F.G % 8 == 0) ? (bx % 8) * (F.G / 8) + bx / 8 : bx; }
    unsigned char* ws = args.ws;
    F.ctl = (gu32*)(ws + WS_CTL);
    for (int u = F.tid; u < (LDS_BYTES - LDSCTL_OFF) / 4; u += NWAVES * 64) ((LAS unsigned*)(F.lds + LDSCTL_OFF))[u] = 0u;
    __syncthreads();
    const int lo = args.ph_lo, hi = args.ph_hi;
    XcdBarrier bar; bar.bar = (unsigned*)(F.ctl + CW_BAR); bar.x = 0; bar.st = nullptr;
    if (hi - lo > 1) bar = xcd_barrier_post((unsigned*)(F.ctl + CW_BAR), F.MISC + 8);
#define IN(k) (lo <= (k) && (k) < hi)
#define SEAM(k) do { if (IN(k) && IN((k) + 1)) xcd_barrier(bar); } while (0)

    if (IN(0)) { p0_prologue(F, args); p0_bias_tiles(F, args); SEAM(0); }
    if (IN(1)) { p1_norm(F, args); SEAM(1); }
    if (IN(2)) {
        { pg8::Gemm g{(const pg8::bf16_t*)(ws + WS_HX), (const pg8::bf16_t*)(ws + WS_WIN), M, NIN, D}; pg8::StaticOrder S; S.init(M, NIN, F.G, (int)blockIdx.x);
          pg8::EpiInProj E{(pg8::bf16_t*)(ws + WS_Q), (pg8::bf16_t*)(ws + WS_QROT), (pg8::bf16_t*)(ws + WS_KROT), (pg8::bf16_t*)(ws + WS_V), (pg8::bf16_t*)(ws + WS_HG), (const float*)(ws + WS_ROPE)};
          pg8::gemm_phase<pg8::EpiInProj, pg8::StaticOrder, true, true>(F.lds + RING_OFF, g, S, E); }
        { pg8::Gemm g{(const pg8::bf16_t*)(ws + WS_HC), (const pg8::bf16_t*)(ws + WS_WIN) + (size_t)512 * D, MC, 1024, D}; pg8::StaticOrder S; S.init(MC, 1024, F.G, (int)blockIdx.x);
          pg8::EpiCtx E{(pg8::bf16_t*)(ws + WS_KC), (pg8::bf16_t*)(ws + WS_VC)};
          pg8::gemm_phase<pg8::EpiCtx, pg8::StaticOrder, true, true>(F.lds + RING_OFF, g, S, E); }
        SEAM(2);
    }
    if (IN(3)) {
#if defined(ATTN_NAIVE)
        p3_attn_naive(F, args);
#else
        p3_attention(F, args);
#if defined(DBG_E1)
        xcd_barrier(bar);
        p3_attn_dbg_e1(F, args);
#endif
#if defined(DBG_E3)
        xcd_barrier(bar);
        p3_attn_dbg_e3(F, args);
#endif
#endif
        p3_conv_naive(F, args); SEAM(3); }
    if (IN(4)) {
        pg8::Gemm g{(const pg8::bf16_t*)(ws + WS_MIX), (const pg8::bf16_t*)(ws + WS_WOUT), M, D, D}; pg8::StaticOrder S; S.init(M, D, F.G, (int)blockIdx.x);
        pg8::EpiOutProj E{args.in[0], args.out, (pg8::bf16_t*)(ws + WS_XS), (float*)(ws + WS_SSQ), (const float*)(ws + WS_MOD), (const float*)(ws + WS_S2)};
        pg8::gemm_phase<pg8::EpiOutProj, pg8::StaticOrder, true, true>(F.lds + RING_OFF, g, S, E);
        SEAM(4);
    }
    if (IN(5)) {
        pg8::Gemm g{(const pg8::bf16_t*)(ws + WS_XS), (const pg8::bf16_t*)(ws + WS_W1), M, FF, D}; pg8::StaticOrder S; S.init(M, FF, F.G, (int)blockIdx.x);
        pg8::EpiMlp1 E{(pg8::bf16_t*)(ws + WS_HID), (const float*)(ws + WS_SSQ), (const float*)(ws + WS_BIAS2), EPS};
        pg8::gemm_phase<pg8::EpiMlp1, pg8::StaticOrder, true, true>(F.lds + RING_OFF, g, S, E);
        SEAM(5);
    }
    if (IN(6)) {
        pg8::Gemm g{(const pg8::bf16_t*)(ws + WS_HID), (const pg8::bf16_t*)(ws + WS_W2), M, D, FF}; pg8::StaticOrder S; S.init(M, D, F.G, (int)blockIdx.x);
        pg8::EpiMlp2 E{args.out, (float*)(ws + WS_SSQ2), (const float*)(ws + WS_MOD)};
        pg8::gemm_phase<pg8::EpiMlp2, pg8::StaticOrder, true, true>(F.lds + RING_OFF, g, S, E);
        SEAM(6);
    }
    if (IN(7)) { p7_final(F, args); }
#undef IN
#undef SEAM
}

extern "C" void kernel_launch(void* const* d_in, const int* in_sizes, int n_in, void* d_out, int out_size, void* d_ws, size_t ws_size, hipStream_t stream) {
    static int grid = 0;
    if (grid == 0) {
        if (n_in != 18 || in_sizes[0] != M * D || out_size != M * D || ws_size < WS_END2) { fprintf(stderr, "kernel_launch: unexpected shapes (n_in %d, in0 %d, out %d, ws %zu)\n", n_in, n_in > 0 ? in_sizes[0] : -1, out_size, ws_size); grid = -1; return; }
        int dev = 0, cus = 0, per_cu = 0;
        if (hipGetDevice(&dev) != hipSuccess || hipDeviceGetAttribute(&cus, hipDeviceAttributeMultiprocessorCount, dev) != hipSuccess) { grid = -1; return; }
        if (hipFuncSetAttribute((const void*)hymba_fwd, hipFuncAttributeMaxDynamicSharedMemorySize, LDS_BYTES) != hipSuccess) { fprintf(stderr, "kernel_launch: hipFuncSetAttribute failed\n"); grid = -1; return; }
        if (hipOccupancyMaxActiveBlocksPerMultiprocessor(&per_cu, (const void*)hymba_fwd, NWAVES * 64, LDS_BYTES) != hipSuccess || per_cu < 1) { fprintf(stderr, "kernel_launch: occupancy query says %d\n", per_cu); per_cu = 1; }
        (void)hipGetLastError();
        grid = cus;
    }
    if (grid < 0) return;
    if (hipMemsetAsync((char*)d_ws + WS_CTL, 0, CTL_ZERO_BYTES, stream) != hipSuccess) return;
    Args a{};
    for (int i = 0; i < 18; ++i) a.in[i] = (const float*)d_in[i];
    a.out = (float*)d_out; a.ws = (unsigned char*)d_ws;
#if MK_N_LAUNCHES == 1
    a.ph_lo = 0; a.ph_hi = N_PHASES;
    hipLaunchKernelGGL(hymba_fwd, dim3(grid), dim3(NWAVES * 64), LDS_BYTES, stream, a);
#else
    for (int p = 0; p < N_PHASES; ++p) { a.ph_lo = p; a.ph_hi = p + 1; hipLaunchKernelGGL(hymba_fwd, dim3(grid), dim3(NWAVES * 64), LDS_BYTES, stream, a); }
#endif
}
```
